# Optimizing an MI355X kernel written in HIP

```python
import jax, jax.numpy as jnp
from jax import lax
import numpy as np

D_MODEL = 1024
BATCH = 8
SEQ = 2048
DEPTH = 2

N_META = 16
BLOCK = 128
SSD_HEADS = 8
SSD_HEAD_DIM = 64
SSD_D = SSD_HEADS * SSD_HEAD_DIM
SSD_GROUPS = 2
SSD_STATE = 64
SSD_CONV = 4
SSD_CONV_DIM = SSD_D + 2 * SSD_GROUPS * SSD_STATE
FOX_HEADS = 4
FOX_HEAD_DIM = 64
FOX_D = FOX_HEADS * FOX_HEAD_DIM
MLA_HEADS = 4
MLA_Q_LORA = 256
MLA_KV_LORA = 128
MLA_NOPE = 64
MLA_ROPE = 32
MLA_V = 64
MLA_D = MLA_HEADS * MLA_V
ROPE_THETA = 10000.0
D_MIX = SSD_D + FOX_D + MLA_D
IN_SIZES = [SSD_D, SSD_CONV_DIM, SSD_HEADS,
            FOX_D, FOX_D, FOX_D, FOX_HEADS,
            MLA_Q_LORA, MLA_KV_LORA, MLA_ROPE]
N_IN = sum(IN_SIZES)
IN_SPLITS = [int(s) for s in np.cumsum(IN_SIZES)[:-1]]
D_FF = 2816
ALPHA = (2 * DEPTH) ** 0.25
BETA = (8 * DEPTH) ** -0.25
EPS = 1e-5

kernel_name = "hybrid_ssd_fox_mla_macaron_deepnorm"


def layer_norm(x, g, b):
    xf = x.astype(jnp.float32)
    mu = jnp.mean(xf, -1, keepdims=True)
    var = jnp.mean(jnp.square(xf - mu), -1, keepdims=True)
    return ((xf - mu) * lax.rsqrt(var + EPS) * g + b).astype(x.dtype)


def rms_norm(x, g):
    xf = x.astype(jnp.float32)
    y = xf * lax.rsqrt(jnp.mean(jnp.square(xf), -1, keepdims=True) + EPS)
    return (y * g).astype(x.dtype)


def swiglu(x, w_gate, w_up, w_down):
    return (jax.nn.silu(x @ w_gate) * (x @ w_up)) @ w_down


def rope(x, cos, sin):
    x1, x2 = jnp.split(x.astype(jnp.float32), 2, axis=-1)
    return jnp.concatenate([x1 * cos - x2 * sin, x2 * cos + x1 * sin], -1).astype(x.dtype)


def block_edges(total):
    return sorted(set([0] + list(range(N_META, total, BLOCK)) + [total]))


def blocked_causal_attention(logits_fn, v):
    total = v.shape[1]
    outs = []
    edges = block_edges(total)
    for q0, q1 in zip(edges[:-1], edges[1:]):
        s = logits_fn(q0, q1).astype(jnp.float32)
        causal = jnp.arange(q1)[None, :] <= jnp.arange(q0, q1)[:, None]
        s = jnp.where(causal, s, -jnp.inf)
        p = jax.nn.softmax(s, axis=-1).astype(v.dtype)
        outs.append(jnp.einsum('bhqk,bkhd->bqhd', p, v[:, :q1]))
    return jnp.concatenate(outs, axis=1)


def causal_depthwise_conv(x, w, bias):
    out = lax.conv_general_dilated(
        x, w[:, None, :], window_strides=(1,), padding=[(SSD_CONV - 1, 0)],
        dimension_numbers=('NWC', 'WIO', 'NWC'), feature_group_count=x.shape[-1])
    return out + bias


def ssd_chunked(x, dt, A, Bm, Cm):
    b, l, h, p = x.shape
    n = Bm.shape[-1]
    nc = l // BLOCK
    x = x.reshape(b, nc, BLOCK, h, p)
    dt = dt.reshape(b, nc, BLOCK, h)
    Bm = Bm.reshape(b, nc, BLOCK, h, n)
    Cm = Cm.reshape(b, nc, BLOCK, h, n)
    a = jnp.moveaxis(dt * A, -1, 1)
    a_cum = jnp.cumsum(a, axis=-1)
    xdt = x * dt[..., None]
    idx = jnp.arange(BLOCK)
    causal = idx[:, None] >= idx[None, :]
    seg = jnp.exp(jnp.where(causal, a_cum[..., :, None] - a_cum[..., None, :], -jnp.inf))
    cb = jnp.einsum('bclhn,bcshn->bhcls', Cm, Bm)
    y_diag = jnp.einsum('bhcls,bcshp->bclhp', cb * seg, xdt)
    decay_states = jnp.exp(a_cum[..., -1:] - a_cum)
    states = jnp.einsum('bclhn,bhcl,bclhp->bchpn', Bm, decay_states, xdt)
    chunk_decay = jnp.exp(a_cum[..., -1])

    def step(s, inp):
        st, dec = inp
        return s * dec[..., None, None] + st, s

    init = jnp.zeros((b, h, p, n), x.dtype)
    _, prev = lax.scan(step, init, (jnp.moveaxis(states, 1, 0), jnp.moveaxis(chunk_decay, 2, 0)))
    prev = jnp.moveaxis(prev, 0, 1)
    y_off = jnp.einsum('bclhn,bchpn,bhcl->bclhp', Cm, prev, jnp.exp(a_cum))
    return (y_diag + y_off).reshape(b, l, h, p)


def ssd_mixer(z, xbc, dt_raw, conv_w, conv_b, dt_bias, a_log, d_skip, norm_g):
    b, L, _ = xbc.shape
    f32 = jnp.float32
    xbc = jax.nn.silu(causal_depthwise_conv(xbc, conv_w, conv_b)).astype(f32)
    xs, Bm, Cm = jnp.split(xbc, [SSD_D, SSD_D + SSD_GROUPS * SSD_STATE], axis=-1)
    xs = xs.reshape(b, L, SSD_HEADS, SSD_HEAD_DIM)
    rep = SSD_HEADS // SSD_GROUPS
    Bm = jnp.repeat(Bm.reshape(b, L, SSD_GROUPS, SSD_STATE), rep, axis=2)
    Cm = jnp.repeat(Cm.reshape(b, L, SSD_GROUPS, SSD_STATE), rep, axis=2)
    dt = jax.nn.softplus(dt_raw.astype(f32) + dt_bias.astype(f32))
    A = -jnp.exp(a_log.astype(f32))
    pad = (-L) % BLOCK
    padf = lambda t: jnp.pad(t, ((0, 0), (pad, 0)) + ((0, 0),) * (t.ndim - 2))
    y = ssd_chunked(padf(xs), padf(dt), A, padf(Bm), padf(Cm))[:, pad:]
    y = y + d_skip.astype(f32)[:, None] * xs
    y = y.reshape(b, L, SSD_D) * jax.nn.silu(z.astype(f32))
    y = rms_norm(y.reshape(b, L, SSD_GROUPS, SSD_D // SSD_GROUPS), 1.0).reshape(b, L, SSD_D) * norm_g
    return y.astype(z.dtype)


def fox_mixer(q, k, v, f_raw, f_b):
    b, L, _ = q.shape
    q = q.reshape(b, L, FOX_HEADS, FOX_HEAD_DIM)
    k = k.reshape(b, L, FOX_HEADS, FOX_HEAD_DIM)
    v = v.reshape(b, L, FOX_HEADS, FOX_HEAD_DIM)
    log_f = jax.nn.log_sigmoid(f_raw.astype(jnp.float32) + f_b.astype(jnp.float32))
    c = jnp.cumsum(log_f, axis=1).transpose(0, 2, 1)
    scale = FOX_HEAD_DIM ** -0.5

    def logits(q0, q1):
        s = jnp.einsum('bqhd,bkhd->bhqk', q[:, q0:q1], k[:, :q1]).astype(jnp.float32) * scale
        return s + (c[:, :, q0:q1, None] - c[:, :, None, :q1])

    return blocked_causal_attention(logits, v).reshape(b, L, FOX_D)


def mla_mixer(cq, ckv, k_rope, q_norm_g, w_uq, kv_norm_g, w_ukv, cos, sin):
    b, L, _ = cq.shape
    qh = (rms_norm(cq, q_norm_g) @ w_uq).reshape(b, L, MLA_HEADS, MLA_NOPE + MLA_ROPE)
    q_nope, q_rope = qh[..., :MLA_NOPE], qh[..., MLA_NOPE:]
    q_rope = rope(q_rope, cos[None, :, None, :], sin[None, :, None, :])
    kv = (rms_norm(ckv, kv_norm_g) @ w_ukv).reshape(b, L, MLA_HEADS, MLA_NOPE + MLA_V)
    k_nope, v = kv[..., :MLA_NOPE], kv[..., MLA_NOPE:]
    k_rope = rope(k_rope, cos[None], sin[None])
    scale = (MLA_NOPE + MLA_ROPE) ** -0.5

    def logits(q0, q1):
        s = jnp.einsum('bqhd,bkhd->bhqk', q_nope[:, q0:q1], k_nope[:, :q1])
        s = s + jnp.einsum('bqhr,bkr->bhqk', q_rope[:, q0:q1], k_rope[:, :q1])
        return s * scale

    return blocked_causal_attention(logits, v).reshape(b, L, MLA_D)


def setup_inputs(seed: int = 0) -> dict:
    key = jax.random.key(seed)
    ks = iter(jax.random.split(key, 48))
    f32 = jnp.float32
    Dm, F, NL = D_MODEL, D_FF, DEPTH

    def nrm(shape, scale):
        return jax.random.normal(next(ks), shape, f32) * scale

    def gain(shape):
        return 1.0 + nrm(shape, 0.02)

    u = jax.random.uniform(next(ks), (NL, SSD_HEADS), f32)
    dt0 = jnp.exp(u * (np.log(0.1) - np.log(0.001)) + np.log(0.001))
    dt_bias = dt0 + jnp.log(-jnp.expm1(-dt0))
    a_log = jnp.log(jax.random.uniform(next(ks), (NL, SSD_HEADS), f32, 1.0, 16.0))
    return {
        "x": nrm((BATCH, SEQ, Dm), 1.0),
        "meta": nrm((N_META, Dm), 1.0),
        "ffn1_w_gate": nrm((NL, Dm, F), Dm ** -0.5),
        "ffn1_w_up": nrm((NL, Dm, F), Dm ** -0.5),
        "ffn1_w_down": nrm((NL, F, Dm), F ** -0.5 * BETA),
        "ln1_g": gain((NL, Dm)),
        "ln1_b": nrm((NL, Dm), 0.02),
        "w_in": nrm((NL, Dm, N_IN), Dm ** -0.5),
        "conv_w": nrm((NL, SSD_CONV, SSD_CONV_DIM), SSD_CONV ** -0.5),
        "conv_b": nrm((NL, SSD_CONV_DIM), 0.02),
        "dt_bias": dt_bias,
        "a_log": a_log,
        "d_skip": gain((NL, SSD_HEADS)),
        "ssd_norm_g": gain((NL, SSD_D)),
        "fox_f_b": 3.0 + nrm((NL, FOX_HEADS), 0.5),
        "mla_q_norm_g": gain((NL, MLA_Q_LORA)),
        "mla_w_uq": nrm((NL, MLA_Q_LORA, MLA_HEADS * (MLA_NOPE + MLA_ROPE)), MLA_Q_LORA ** -0.5),
        "mla_kv_norm_g": gain((NL, MLA_KV_LORA)),
        "mla_w_ukv": nrm((NL, MLA_KV_LORA, MLA_HEADS * (MLA_NOPE + MLA_V)), MLA_KV_LORA ** -0.5),
        "w_out": nrm((NL, D_MIX, Dm), D_MIX ** -0.5 * BETA),
        "ln2_g": gain((NL, Dm)),
        "ln2_b": nrm((NL, Dm), 0.02),
        "ffn2_w_gate": nrm((NL, Dm, F), Dm ** -0.5),
        "ffn2_w_up": nrm((NL, Dm, F), Dm ** -0.5),
        "ffn2_w_down": nrm((NL, F, Dm), F ** -0.5 * BETA),
        "ln3_g": gain((NL, Dm)),
        "ln3_b": nrm((NL, Dm), 0.02),
    }


def reference(x, meta, ffn1_w_gate, ffn1_w_up, ffn1_w_down, ln1_g, ln1_b, w_in,
              conv_w, conv_b, dt_bias, a_log, d_skip, ssd_norm_g, fox_f_b,
              mla_q_norm_g, mla_w_uq, mla_kv_norm_g, mla_w_ukv, w_out, ln2_g, ln2_b,
              ffn2_w_gate, ffn2_w_up, ffn2_w_down, ln3_g, ln3_b):
    b = x.shape[0]
    h = jnp.concatenate([jnp.broadcast_to(meta[None].astype(x.dtype), (b, N_META, D_MODEL)), x], axis=1)
    total = h.shape[1]
    pos = jnp.arange(total, dtype=jnp.float32)
    inv_freq = 1.0 / (ROPE_THETA ** (jnp.arange(0, MLA_ROPE, 2, dtype=jnp.float32) / MLA_ROPE))
    ang = pos[:, None] * inv_freq[None, :]
    cos, sin = jnp.cos(ang), jnp.sin(ang)

    for l in range(DEPTH):
        h = layer_norm(ALPHA * h + 0.5 * swiglu(h, ffn1_w_gate[l], ffn1_w_up[l], ffn1_w_down[l]),
                       ln1_g[l], ln1_b[l])
        proj = h @ w_in[l]
        (z, xbc, dt_raw, fq, fk, fv, f_raw, cq, ckv, k_rope) = jnp.split(proj, IN_SPLITS, axis=-1)
        y_ssd = ssd_mixer(z, xbc, dt_raw, conv_w[l], conv_b[l], dt_bias[l], a_log[l],
                          d_skip[l], ssd_norm_g[l])
        y_fox = fox_mixer(fq, fk, fv, f_raw, fox_f_b[l])
        y_mla = mla_mixer(cq, ckv, k_rope, mla_q_norm_g[l], mla_w_uq[l], mla_kv_norm_g[l],
                          mla_w_ukv[l], cos, sin)
        mix = jnp.concatenate([y_ssd, y_fox.astype(h.dtype), y_mla.astype(h.dtype)], axis=-1) @ w_out[l]
        h = layer_norm(ALPHA * h + mix, ln2_g[l], ln2_b[l])
        h = layer_norm(ALPHA * h + 0.5 * swiglu(h, ffn2_w_gate[l], ffn2_w_up[l], ffn2_w_down[l]),
                       ln3_g[l], ln3_b[l])
    return h[:, N_META:]
```

```cpp
#include <hip/hip_runtime.h>
#include <hip/hip_cooperative_groups.h>
#include <cstdio>
#include <cstdint>
#include <type_traits>
namespace cg = cooperative_groups;

#ifndef PH_MASK
#define PH_MASK 0x1ff
#endif
#define EN(n) ((MASK >> (n)) & 1)


#ifndef MK_LAUNCHES
#define MK_LAUNCHES 1
#endif
#if MK_LAUNCHES != 1
#define NO_LOOP 1
#endif

#define LAS __attribute__((address_space(3)))
typedef unsigned short bf16_t;
typedef short bf16x8 __attribute__((ext_vector_type(8)));
typedef short s16x4 __attribute__((ext_vector_type(4)));
typedef float f32x4 __attribute__((ext_vector_type(4)));
typedef float f32x2 __attribute__((ext_vector_type(2)));
typedef unsigned u32x4 __attribute__((ext_vector_type(4)));
typedef unsigned u32x2 __attribute__((ext_vector_type(2)));

constexpr int NB = 8, SEQ = 2048, NMETA = 16, LTOT = 2064, DM = 1024, DFF = 2816;
constexpr int RMAIN = NB * SEQ;
constexpr int RT = RMAIN + NMETA;
constexpr int LP = 2080;
constexpr int NIN = 2476;
constexpr float ALPHA = 1.4142135623730951f;
constexpr float EPS = 1e-5f;
constexpr float LOG2E = 1.4426950408889634f;
constexpr float FOX_QS = 0.125f * LOG2E;
constexpr float MLA_QS = 0.10206207261596575f * LOG2E;

constexpr size_t al256(size_t x) { return (x + 255) & ~(size_t)255; }
constexpr size_t WS_CTL = 0;
constexpr size_t WS_BAR = 4096;
constexpr size_t WS_HMETA = 4096 + 16384;
constexpr size_t WS_ROPE = al256(WS_HMETA + (size_t)NMETA * DM * 4);
constexpr size_t WS_SSQQ = al256(WS_ROPE + (size_t)LTOT * 16 * 8);
constexpr size_t WS_SSQKV = al256(WS_SSQQ + (size_t)RT * 16);
constexpr size_t WS_SSQS = al256(WS_SSQKV + (size_t)RT * 16);
constexpr size_t WS_DTV = al256(WS_SSQS + (size_t)RT * 8 * 4);
constexpr size_t WS_CB = al256(WS_DTV + (size_t)RT * 8 * 4);
constexpr size_t WS_SMALL = al256(WS_CB + (size_t)NB * 4 * LP * 4);
constexpr size_t WS_WGU1 = al256(WS_SMALL + (size_t)RT * 64 * 4);
constexpr size_t WS_WD1 = al256(WS_WGU1 + (size_t)2 * DFF * DM * 2);
constexpr size_t WS_WGU2 = al256(WS_WD1 + (size_t)DM * DFF * 2);
constexpr size_t WS_WD2 = al256(WS_WGU2 + (size_t)2 * DFF * DM * 2);
constexpr size_t WS_WIN = al256(WS_WD2 + (size_t)DM * DFF * 2);
constexpr size_t WS_WOUT = al256(WS_WIN + (size_t)2560 * DM * 2);
constexpr size_t WS_WUQ = al256(WS_WOUT + (size_t)DM * DM * 2);
constexpr size_t WS_WUKV = al256(WS_WUQ + (size_t)512 * 256 * 2);
constexpr size_t WS_HB = al256(WS_WUKV + (size_t)512 * 128 * 2);
constexpr size_t WS_ACT = al256(WS_HB + (size_t)RT * DM * 2);
constexpr size_t WS_Z = WS_ACT;
constexpr size_t WS_XBC = al256(WS_Z + (size_t)RT * 512 * 2);
constexpr size_t WS_FQ = al256(WS_XBC + (size_t)RT * 768 * 2);
constexpr size_t WS_FK = al256(WS_FQ + (size_t)RT * 256 * 2);
constexpr size_t WS_CQ = al256(WS_FK + (size_t)RT * 256 * 2);
constexpr size_t WS_CKV = al256(WS_CQ + (size_t)RT * 256 * 2);
constexpr size_t WS_ACT_END = al256(WS_ACT + (size_t)RT * DFF * 2);
constexpr size_t WS_FV = al256(WS_CKV + (size_t)RT * 128 * 2);
static_assert(WS_FV + (size_t)RT * 256 * 2 <= WS_ACT_END, "mixer buffers overflow the act alias");
constexpr size_t WS_XC = WS_ACT_END;
constexpr size_t WS_BN = al256(WS_XC + (size_t)RT * 512 * 2);
constexpr size_t WS_CN = al256(WS_BN + (size_t)RT * 128 * 2);
constexpr size_t WS_XT = al256(WS_CN + (size_t)RT * 128 * 2);
constexpr size_t WS_BT = al256(WS_XT + (size_t)NB * 512 * LP * 2);
constexpr size_t WS_QM = al256(WS_BT + (size_t)NB * 128 * LP * 2);
constexpr size_t WS_KM = al256(WS_QM + (size_t)RT * 384 * 2);
constexpr size_t WS_VM = al256(WS_KM + (size_t)RT * 384 * 2);
constexpr size_t WS_END = al256(WS_VM + (size_t)RT * 256 * 2);
static_assert(WS_END <= (size_t)268435456, "workspace map exceeds 256 MiB");

constexpr int LDS_BYTES = 135168;

__device__ __forceinline__ float bf2f(unsigned v) { return __uint_as_float(v << 16); }
__device__ __forceinline__ unsigned pk2(float lo, float hi) { unsigned r; asm("v_cvt_pk_bf16_f32 %0, %1, %2" : "=v"(r) : "v"(lo), "v"(hi)); return r; }
__device__ __forceinline__ float fast_exp2(float x) { return __builtin_amdgcn_exp2f(x); }
__device__ __forceinline__ float silu_f(float x) { return x * __builtin_amdgcn_rcpf(1.f + fast_exp2(-x * LOG2E)); }
__device__ __forceinline__ int row_of(int b, int pos) { return pos < NMETA ? RMAIN + pos : b * SEQ + pos - NMETA; }
__device__ __forceinline__ int pos_of_row(int row) { return row < RMAIN ? NMETA + (row & (SEQ - 1)) : row - RMAIN; }
#define LDS_WAIT() asm volatile("s_waitcnt lgkmcnt(0)" ::: "memory")
__device__ __forceinline__ float ssq4(const float* p, int row) { const f32x4 q = *(const f32x4*)(p + (size_t)row * 4); return (q[0] + q[1]) + (q[2] + q[3]); }
__device__ __forceinline__ f32x4 zero_acc() { f32x4 z = {0.f, 0.f, 0.f, 0.f}; asm volatile("" : "+v"(z)); return z; }
__device__ __forceinline__ float wave_sum(float v) {
#define WS_DPP(ctrl) v += __builtin_bit_cast(float, __builtin_amdgcn_update_dpp(0, __builtin_bit_cast(int, v), ctrl, 0xf, 0xf, true))
    WS_DPP(0xB1); WS_DPP(0x4E); WS_DPP(0x141); WS_DPP(0x140);
#undef WS_DPP
    v += __shfl_xor(v, 16); v += __shfl_xor(v, 32);
    return v;
}

namespace pg8 {
constexpr int BM = 256, BK = 64, HALF = 128, HTB = HALF * BK * 2, STAGE_BYTES = 8 * HTB, NXCD = 8, WGM = 8;
__host__ __device__ __forceinline__ int lds_byte(int r, int c) { const int st = (r >> 4) * 2 + (c >> 5), rr = r & 15, cc = c & 31, ob = rr * 64 + cc * 2; return st * 1024 + (ob ^ (((ob >> 9) & 1) << 5)); }
__host__ __device__ __forceinline__ void stage_rc(int b, int& R, int& C) { const int st = b / 1024, sb = b % 1024, swz = sb ^ (((sb >> 9) & 1) << 5); R = (st >> 1) * 16 + swz / 64; C = (st & 1) * 32 + (swz % 64) / 2; }
__host__ __device__ __forceinline__ int perm32(int rho) { const int n = rho >> 4, i = rho & 15; return 8 * (i >> 2) + 4 * n + (i & 3); }
struct Unit { int pm, pn; };
struct Gemm { const bf16_t* A; const bf16_t* Bt; int M, N, K; };
struct StaticOrder {
    int nM, nN, nwg, G, c;
    __device__ void init(int M, int N, int G_, int c_) { nM = M / BM; nN = N / BM; nwg = nM * nN; G = __builtin_amdgcn_readfirstlane(G_); c = __builtin_amdgcn_readfirstlane(c_); }
    __device__ bool next(int i, Unit& u) const {
        const long L = (long)i * G + c; if (L >= nwg) return false;
        int wgid = (int)L; { const int q = nwg / NXCD, r = nwg % NXCD, xcd = wgid % NXCD, off = wgid / NXCD; wgid = (xcd < r ? xcd * (q + 1) : r * (q + 1) + (xcd - r) * q) + off; }
        const int nig = WGM * nN, gid = wgid / nig, fm = gid * WGM, gsz = (nM - fm) < WGM ? (nM - fm) : WGM;
        u.pm = __builtin_amdgcn_readfirstlane(fm + ((wgid % nig) % gsz)); u.pn = __builtin_amdgcn_readfirstlane((wgid % nig) / gsz); return true;
    }
    __device__ __forceinline__ void a_ready(const Unit&) const {}
    __device__ __forceinline__ void done(const Unit&) const {}
};
template <class Epi, class Sched, bool ALIGN_EPI>
__device__ __forceinline__ void gemm_phase(LAS unsigned char* lds, const Gemm g, const Sched& S, const Epi& E) {
    const int tid = threadIdx.x, wid = __builtin_amdgcn_readfirstlane(tid >> 6), lane = tid & 63, wr = wid >> 2, wc = wid & 3, fr = lane & 15, fq = lane >> 4;
    int K = g.K; asm volatile("" : "+s"(K));
    const int nt = K / BK;
    unsigned voffA[2], voffB[2];
#pragma unroll
    for (int i = 0; i < 2; ++i) { int R, C; stage_rc(tid * 16 + i * 8192, R, C); const int Rb = E.perm() ? ((R & ~31) + perm32(R & 31)) : R;
        voffA[i] = (unsigned)(R * K + C) * 2u; voffB[i] = (unsigned)(Rb * K + C) * 2u; }
    const size_t kstep = (size_t)(BK * 2);
    const size_t hstep = (size_t)HALF * K * 2;
    const size_t tstep = 2 * hstep;
    const unsigned ldsw = (unsigned)wid * 1024u;
    const int aoff = lds_byte(wr * 64 + fr, fq * 8), boff = lds_byte(wc * 32 + fr, fq * 8);
#define PG8_SA(b, h) (((b) * 2 + (h)) * HTB)
#define PG8_SB(b, h) ((4 + (b) * 2 + (h)) * HTB)
#define PG8_STAGE(bufoff, gbase, voff) do { _Pragma("unroll") for (int _i = 0; _i < 2; ++_i) \
        __builtin_amdgcn_global_load_lds((const unsigned*)((const char*)(gbase) + (voff)[_i]), (LAS unsigned*)(lds + (bufoff) + ldsw + _i * 8192), 16, 0, 0); } while (0)
#define PG8_LDA(dst, b, h) do { _Pragma("unroll") for (int m = 0; m < 4; ++m) _Pragma("unroll") for (int k = 0; k < 2; ++k) dst[m][k] = *(const LAS bf16x8*)(lds + PG8_SA(b, h) + aoff + m * 2048 + k * 1024); } while (0)
#define PG8_LDB(dst, b, h) do { _Pragma("unroll") for (int n = 0; n < 2; ++n) _Pragma("unroll") for (int k = 0; k < 2; ++k) dst[n][k] = *(const LAS bf16x8*)(lds + PG8_SB(b, h) + boff + n * 2048 + k * 1024); } while (0)
#define PG8_MMA(ai, bj, At, Bt) do { __builtin_amdgcn_s_setprio(1); _Pragma("unroll") for (int m = 0; m < 4; ++m) _Pragma("unroll") for (int n = 0; n < 2; ++n) _Pragma("unroll") for (int k = 0; k < 2; ++k) \
        acc[ai][bj][m][n] = __builtin_amdgcn_mfma_f32_16x16x32_bf16(Bt[n][k], At[m][k], acc[ai][bj][m][n], 0, 0, 0); __builtin_amdgcn_s_setprio(0); } while (0)
#define PG8_WAIT_V(n) asm volatile("s_waitcnt vmcnt(" #n ")" ::: "memory")
#define PG8_WAIT_L(n) asm volatile("s_waitcnt lgkmcnt(" #n ")" ::: "memory")
#define PG8_BAR __builtin_amdgcn_s_barrier()
#define PG8_SCHED __builtin_amdgcn_sched_barrier(0)
    Unit cur, nxt; int ui = 0;
    if (!S.next(0, cur)) return;
    f32x4 acc[2][2][4][2];
#pragma unroll
    for (int a = 0; a < 2; ++a)
#pragma unroll
        for (int b = 0; b < 2; ++b)
#pragma unroll
            for (int m = 0; m < 4; ++m)
#pragma unroll
                for (int n = 0; n < 2; ++n) acc[a][b][m][n] = (f32x4){0.f, 0.f, 0.f, 0.f};
    bf16x8 At[4][2], B0[2][2], B1[2][2];
    const char* cA = (const char*)g.A + (size_t)cur.pm * tstep; const char* cB = (const char*)g.Bt + (size_t)cur.pn * tstep;
    PG8_STAGE(PG8_SB(0, 0), cB, voffB); PG8_STAGE(PG8_SB(0, 1), cB + hstep, voffB); PG8_STAGE(PG8_SA(0, 0), cA, voffA); PG8_STAGE(PG8_SA(0, 1), cA + hstep, voffA);
    if (wr == 1) PG8_BAR;
    PG8_WAIT_V(2); PG8_BAR;
    PG8_STAGE(PG8_SB(1, 0), cB + kstep, voffB); PG8_STAGE(PG8_SA(1, 0), cA + kstep, voffA); PG8_STAGE(PG8_SB(1, 1), cB + hstep + kstep, voffB);
    PG8_WAIT_V(6); PG8_BAR;
    for (;;) {
        const bool has_next = S.next(ui + 1, nxt);
        const char* nA = has_next ? (const char*)g.A + (size_t)nxt.pm * tstep : cA; const char* nB = has_next ? (const char*)g.Bt + (size_t)nxt.pn * tstep : cB;
        for (int t = 0; t < nt; t += 2) {
            const bool last = (t == nt - 2);
            const char* a1 = cA + (size_t)(t + 1) * kstep;
            const char* a2 = last ? nA : cA + (size_t)(t + 2) * kstep; const char* b2 = last ? nB : cB + (size_t)(t + 2) * kstep;
            const char* a3 = a2 + kstep; const char* b3 = b2 + kstep;
            PG8_LDB(B0, 0, 0); PG8_LDB(B1, 0, 1); PG8_SCHED; PG8_LDA(At, 0, 0); PG8_STAGE(PG8_SA(1, 1), a1 + hstep, voffA);
            PG8_WAIT_V(8); PG8_WAIT_L(0); PG8_BAR; PG8_MMA(0, 0, At, B0); PG8_MMA(0, 1, At, B1); PG8_BAR; PG8_SCHED;
            PG8_LDA(At, 0, 1); PG8_STAGE(PG8_SB(0, 0), b2, voffB); PG8_STAGE(PG8_SB(0, 1), b2 + hstep, voffB); PG8_STAGE(PG8_SA(0, 0), a2, voffA);
            PG8_WAIT_V(8); PG8_WAIT_L(0); PG8_BAR; PG8_MMA(1, 0, At, B0); PG8_MMA(1, 1, At, B1); PG8_BAR; PG8_SCHED;
            PG8_LDB(B0, 1, 0); PG8_LDB(B1, 1, 1); PG8_SCHED; PG8_LDA(At, 1, 0); PG8_STAGE(PG8_SA(0, 1), a2 + hstep, voffA);
            PG8_WAIT_V(8); PG8_WAIT_L(0); PG8_BAR; PG8_MMA(0, 0, At, B0); PG8_MMA(0, 1, At, B1); PG8_BAR; PG8_SCHED;
            PG8_LDA(At, 1, 1); PG8_STAGE(PG8_SB(1, 0), b3, voffB); PG8_STAGE(PG8_SB(1, 1), b3 + hstep, voffB); PG8_STAGE(PG8_SA(1, 0), a3, voffA);
            PG8_WAIT_V(8); PG8_WAIT_L(0); PG8_BAR; PG8_MMA(1, 0, At, B0); PG8_MMA(1, 1, At, B1); PG8_BAR; PG8_SCHED;
        }
        if constexpr (ALIGN_EPI) { if (wr == 0) PG8_BAR; }
        { int pm_ = cur.pm, pn_ = cur.pn, t_ = tid; asm volatile("" : "+s"(pm_), "+s"(pn_), "+v"(t_));
          const int l_ = t_ & 63, w_ = __builtin_amdgcn_readfirstlane(t_ >> 6); Unit cu; cu.pm = pm_; cu.pn = pn_;
          E(acc, cu, w_ >> 2, w_ & 3, l_ & 15, l_ >> 4); }
        if (!has_next) break;
#pragma unroll
        for (int a = 0; a < 2; ++a)
#pragma unroll
            for (int b = 0; b < 2; ++b)
#pragma unroll
                for (int m = 0; m < 4; ++m)
#pragma unroll
                    for (int n = 0; n < 2; ++n) acc[a][b][m][n] = (f32x4){0.f, 0.f, 0.f, 0.f};
        cur = nxt; cA = nA; cB = nB; ++ui;
        if constexpr (ALIGN_EPI) { if (wr == 1) PG8_BAR; }
    }
    PG8_WAIT_V(0);
    if constexpr (!ALIGN_EPI) { if (wr == 0) PG8_BAR; }
    PG8_BAR;
#undef PG8_SA
#undef PG8_SB
#undef PG8_STAGE
#undef PG8_LDA
#undef PG8_LDB
#undef PG8_MMA
#undef PG8_WAIT_V
#undef PG8_WAIT_L
#undef PG8_BAR
#undef PG8_SCHED
}
}
using pg8::Unit;
typedef f32x4 Acc[2][2][4][2];

struct Params { const float* in[27]; float* out; unsigned char* ws; int ph_lo, ph_hi; };
enum { I_X = 0, I_META, I_F1G, I_F1U, I_F1D, I_LN1G, I_LN1B, I_WIN, I_CONVW, I_CONVB, I_DTB, I_ALOG, I_DSKIP, I_SNG, I_FFB, I_QNG, I_WUQ, I_KVNG, I_WUKV, I_WOUT,
       I_LN2G, I_LN2B, I_F2G, I_F2U, I_F2D, I_LN3G, I_LN3B };

__device__ __forceinline__ const float* INP(const Params& p, int i) { asm volatile("" : "+s"(i)); return p.in[i]; }
struct Ctx {
    LAS unsigned char* lds; int tid, lane, wid, bid, G;
    const Params* p; unsigned char* ws;
    float* hmain; float* hmeta;
    template <class T> __device__ __forceinline__ T* W(size_t off) const { return (T*)(ws + off); }
    __device__ __forceinline__ float* hrow(int row) const { return row < RMAIN ? hmain + (size_t)row * DM : hmeta + (size_t)(row - RMAIN) * DM; }
};

template <class F>
__device__ __forceinline__ void meta_unit(const Ctx& c, const bf16_t* A, int lda, const bf16_t* Bt, int ldb, int K, int n0, int off2, const F& f) {
    const int fr = c.lane & 15, fq = c.lane >> 4;
    f32x4 a0 = zero_acc(), a1 = zero_acc();
    const int steps = K / 32;
    const bf16_t* ap = A + (size_t)fr * lda + fq * 8;
    const bf16_t* b0p = Bt + (size_t)(n0 + fr) * ldb + fq * 8;
    const bf16_t* b1p = Bt + (size_t)(n0 + off2 + fr) * ldb + fq * 8;
#pragma unroll 4
    for (int s = c.wid; s < steps; s += 8) {
        const bf16x8 av = *(const bf16x8*)(ap + s * 32);
        const bf16x8 b0 = *(const bf16x8*)(b0p + s * 32);
        const bf16x8 b1 = *(const bf16x8*)(b1p + s * 32);
        a0 = __builtin_amdgcn_mfma_f32_16x16x32_bf16(b0, av, a0, 0, 0, 0);
        a1 = __builtin_amdgcn_mfma_f32_16x16x32_bf16(b1, av, a1, 0, 0, 0);
    }
    LAS f32x4* red = (LAS f32x4*)c.lds;
    red[(c.wid * 2 + 0) * 64 + c.lane] = a0; red[(c.wid * 2 + 1) * 64 + c.lane] = a1;
    __syncthreads();
    if (c.wid == 0) {
        f32x4 s0 = red[c.lane], s1 = red[64 + c.lane];
#pragma unroll
        for (int w = 1; w < 8; ++w) { s0 += red[(w * 2) * 64 + c.lane]; s1 += red[(w * 2 + 1) * 64 + c.lane]; }
        f(fr, n0 + 4 * fq, s0, n0 + off2 + 4 * fq, s1);
    }
    __syncthreads();
}

struct EpiSwiglu {
    static constexpr bool PERM = true;
    bf16_t* act;
    __device__ __forceinline__ void operator()(const Acc& acc, const Unit& u, int wr, int wc, int fr, int fq) const {
        const int row0 = u.pm * 256 + wr * 64 + fr, col0 = u.pn * 128 + wc * 32 + 8 * fq;
#pragma unroll
        for (int ai = 0; ai < 2; ++ai)
#pragma unroll
            for (int m = 0; m < 4; ++m) {
                const f32x4 g0 = acc[ai][0][m][0], g1 = acc[ai][0][m][1], u0 = acc[ai][1][m][0], u1 = acc[ai][1][m][1];
                u32x4 w;
                w.x = pk2(silu_f(g0[0]) * u0[0], silu_f(g0[1]) * u0[1]); w.y = pk2(silu_f(g0[2]) * u0[2], silu_f(g0[3]) * u0[3]);
                w.z = pk2(silu_f(g1[0]) * u1[0], silu_f(g1[1]) * u1[1]); w.w = pk2(silu_f(g1[2]) * u1[2], silu_f(g1[3]) * u1[3]);
                *(u32x4*)(act + (size_t)(row0 + ai * 128 + m * 16) * DFF + col0) = w;
                asm volatile("" ::: "memory");
            }
    }
};
struct EpiResid {
    static constexpr bool PERM = true;
    float* h; float s; const float* base;
    __device__ __forceinline__ void operator()(const Acc& acc, const Unit& u, int wr, int wc, int fr, int fq) const {
        const int row0 = u.pm * 256 + wr * 64 + fr, col0 = u.pn * 256 + wc * 32 + 8 * fq;
#pragma unroll
        for (int ai = 0; ai < 2; ++ai)
#pragma unroll
            for (int m = 0; m < 4; ++m) {
                const size_t ro = (size_t)(row0 + ai * 128 + m * 16) * DM + col0;
#pragma unroll
                for (int bj = 0; bj < 2; ++bj)
#pragma unroll
                    for (int n = 0; n < 2; ++n) { const f32x4 b = *(const f32x4*)(base + ro + bj * 128 + n * 4); *(f32x4*)(h + ro + bj * 128 + n * 4) = b * ALPHA + acc[ai][bj][m][n] * s; }
                asm volatile("" ::: "memory");
            }
    }
};
struct InStore {
    bf16_t *Z, *XBC, *FQ, *FK, *CQ, *CKV; float* SMALL; bf16_t* FV;
    __device__ __forceinline__ void store4(int row, int c, f32x4 v) const {
        if (c < 2048) {
            bf16_t* dst;
            if (c < 512) dst = Z + (size_t)row * 512 + c;
            else if (c < 1280) dst = XBC + (size_t)row * 768 + (c - 512);
            else if (c < 1536) { dst = FQ + (size_t)row * 256 + (c - 1280); }
            else if (c < 1792) dst = FK + (size_t)row * 256 + (c - 1536);
            else dst = CQ + (size_t)row * 256 + (c - 1792);
            u32x2 w; w.x = pk2(v[0], v[1]); w.y = pk2(v[2], v[3]); *(u32x2*)dst = w;
        } else if (c < 2176) {
            u32x2 w; w.x = pk2(v[0], v[1]); w.y = pk2(v[2], v[3]); *(u32x2*)(CKV + (size_t)row * 128 + (c - 2048)) = w;
        } else if (c < 2240) {
            *(f32x4*)(SMALL + (size_t)row * 64 + (c - 2176)) = v;
        } else if (c >= 2304) {
            u32x2 w; w.x = pk2(v[0], v[1]); w.y = pk2(v[2], v[3]); *(u32x2*)(FV + (size_t)row * 256 + (c - 2304)) = w;
        }
    }
};
struct EpiIn {
    static constexpr bool PERM = true;
    unsigned char* ws;
    __device__ __forceinline__ void operator()(const Acc& acc, const Unit& u, int wr, int wc, int fr, int fq) const {
        const int pn = u.pn, row0 = u.pm * 256 + wr * 64 + fr, colw = wc * 32 + 8 * fq;
        if (pn != 8) {
            bf16_t* base; int pitch;
            if (pn < 2) { base = (bf16_t*)(ws + WS_Z) + pn * 256; pitch = 512; }
            else if (pn < 5) { base = (bf16_t*)(ws + WS_XBC) + (pn - 2) * 256; pitch = 768; }
            else if (pn == 5) { base = (bf16_t*)(ws + WS_FQ); pitch = 256; }
            else if (pn == 6) { base = (bf16_t*)(ws + WS_FK); pitch = 256; }
            else if (pn == 7) { base = (bf16_t*)(ws + WS_CQ); pitch = 256; }
            else { base = (bf16_t*)(ws + WS_FV); pitch = 256; }
            float* ssq = (float*)(ws + WS_SSQQ);
#pragma unroll
            for (int ai = 0; ai < 2; ++ai)
#pragma unroll
                for (int m = 0; m < 4; ++m) {
                    const int row = row0 + ai * 128 + m * 16;
                    bf16_t* rp = base + (size_t)row * pitch + colw;
                    float s = 0.f;
#pragma unroll
                    for (int bj = 0; bj < 2; ++bj) {
                        const f32x4 v0 = acc[ai][bj][m][0], v1 = acc[ai][bj][m][1];
                        u32x4 w; w.x = pk2(v0[0], v0[1]); w.y = pk2(v0[2], v0[3]); w.z = pk2(v1[0], v1[1]); w.w = pk2(v1[2], v1[3]);
                        *(u32x4*)(rp + bj * 128) = w;
                        s += v0[0] * v0[0] + v0[1] * v0[1] + v0[2] * v0[2] + v0[3] * v0[3] + v1[0] * v1[0] + v1[1] * v1[1] + v1[2] * v1[2] + v1[3] * v1[3];
                    }
                    if (pn == 7) { s += __shfl_xor(s, 16); s += __shfl_xor(s, 32); if (fq == 0) ssq[(size_t)row * 4 + wc] = s; }
                    asm volatile("" ::: "memory");
                }
        } else {
            bf16_t* ckv = (bf16_t*)(ws + WS_CKV); float* sm = (float*)(ws + WS_SMALL); float* ssq = (float*)(ws + WS_SSQKV);
#pragma unroll
            for (int ai = 0; ai < 2; ++ai)
#pragma unroll
                for (int m = 0; m < 4; ++m) {
                    const int row = row0 + ai * 128 + m * 16;
                    const f32x4 v0 = acc[ai][0][m][0], v1 = acc[ai][0][m][1];
                    u32x4 w; w.x = pk2(v0[0], v0[1]); w.y = pk2(v0[2], v0[3]); w.z = pk2(v1[0], v1[1]); w.w = pk2(v1[2], v1[3]);
                    *(u32x4*)(ckv + (size_t)row * 128 + colw) = w;
                    float s = v0[0] * v0[0] + v0[1] * v0[1] + v0[2] * v0[2] + v0[3] * v0[3] + v1[0] * v1[0] + v1[1] * v1[1] + v1[2] * v1[2] + v1[3] * v1[3];
                    s += __shfl_xor(s, 16); s += __shfl_xor(s, 32); if (fq == 0) ssq[(size_t)row * 4 + wc] = s;
                    if (wc < 2) { *(f32x4*)(sm + (size_t)row * 64 + colw) = acc[ai][1][m][0]; *(f32x4*)(sm + (size_t)row * 64 + colw + 4) = acc[ai][1][m][1]; }
                    asm volatile("" ::: "memory");
                }
        }
    }
};
struct UqStore {
    bf16_t* Qm; const float* ssq_q; const f32x2* rope;
    __device__ __forceinline__ void store(int row, int gb, int i0, f32x4 va, f32x4 vb) const {
        if (gb >= 384) return;
        const float sc = __builtin_amdgcn_rsqf(ssq4(ssq_q, row) * (1.f / 256.f) + EPS) * MLA_QS;
        va = va * sc; vb = vb * sc;
        if ((gb % 96) == 64) {
            const f32x2* rt = rope + (size_t)pos_of_row(row) * 16 + i0;
#pragma unroll
            for (int e = 0; e < 4; ++e) { const f32x2 cs = rt[e]; const float x1 = va[e], x2 = vb[e]; va[e] = x1 * cs.x - x2 * cs.y; vb[e] = x2 * cs.x + x1 * cs.y; }
        }
        u32x2 w; w.x = pk2(va[0], va[1]); w.y = pk2(va[2], va[3]); *(u32x2*)(Qm + (size_t)row * 384 + gb + i0) = w;
        w.x = pk2(vb[0], vb[1]); w.y = pk2(vb[2], vb[3]); *(u32x2*)(Qm + (size_t)row * 384 + gb + 16 + i0) = w;
    }
};
struct EpiUq {
    static constexpr bool PERM = false;
    UqStore st;
    __device__ __forceinline__ void operator()(const Acc& acc, const Unit& u, int wr, int wc, int fr, int fq) const {
        const int row0 = u.pm * 256 + wr * 64 + fr;
#pragma unroll
        for (int ai = 0; ai < 2; ++ai)
#pragma unroll
            for (int m = 0; m < 4; ++m)
                { for (int bj = 0; bj < 2; ++bj) st.store(row0 + ai * 128 + m * 16, u.pn * 256 + bj * 128 + wc * 32, 4 * fq, acc[ai][bj][m][0], acc[ai][bj][m][1]);
                  asm volatile("" ::: "memory"); }
    }
};
struct UkStore {
    bf16_t* Km; const float* ssq_kv;
    __device__ __forceinline__ void store4(int row, int c, f32x4 v) const {
        const float sc = __builtin_amdgcn_rsqf(ssq4(ssq_kv, row) * (1.f / 128.f) + EPS);
        u32x2 w; w.x = pk2(v[0] * sc, v[1] * sc); w.y = pk2(v[2] * sc, v[3] * sc);
        *(u32x2*)(Km + (size_t)row * 384 + (c >> 6) * 96 + (c & 63)) = w;
    }
};
struct EpiUk {
    static constexpr bool PERM = true;
    UkStore st; bf16_t* VtM;
    __device__ __forceinline__ void operator()(const Acc& acc, const Unit& u, int wr, int wc, int fr, int fq) const {
        const int row0 = u.pm * 256 + wr * 64 + fr, col0 = wc * 32 + 8 * fq;
        const bool isv = u.pn == 1;
        const int kc0 = isv ? col0 : (col0 >> 6) * 96 + (col0 & 63);
        bf16_t* dstb = isv ? VtM : st.Km; const int pitch = isv ? 256 : 384, bjoff = isv ? 128 : 192;
#pragma unroll
        for (int ai = 0; ai < 2; ++ai)
#pragma unroll
            for (int m = 0; m < 4; ++m) {
                const int row = row0 + ai * 128 + m * 16;
                const float sc = __builtin_amdgcn_rsqf(ssq4(st.ssq_kv, row) * (1.f / 128.f) + EPS);
                bf16_t* rp = dstb + (size_t)row * pitch + kc0;
#pragma unroll
                for (int bj = 0; bj < 2; ++bj) {
                    const f32x4 v0 = acc[ai][bj][m][0] * sc, v1 = acc[ai][bj][m][1] * sc;
                    u32x4 w; w.x = pk2(v0[0], v0[1]); w.y = pk2(v0[2], v0[3]); w.z = pk2(v1[0], v1[1]); w.w = pk2(v1[2], v1[3]);
                    *(u32x4*)(rp + bj * bjoff) = w;
                }
                asm volatile("" ::: "memory");
            }
    }
};

struct WMap { const float* base; const float* base2; const float* kscale; bf16_t* dst; int ld, K, N, kind; };
__device__ __forceinline__ const float* wmap_col(const WMap& m, int n) {
    switch (m.kind) {
        case 0: return m.base + n;
        case 1: { const int t = n >> 8, w = n & 255; return w < 128 ? m.base + 128 * t + w : m.base2 + 128 * t + (w - 128); }
        case 2: {
            int s;
            if (n < 1280) s = n; else if (n < 1536) s = 1288 + (n - 1280); else if (n < 1792) s = 1544 + (n - 1536); else if (n < 2048) s = 2060 + (n - 1792);
            else if (n < 2176) s = 2316 + (n - 2048); else if (n < 2208) s = 2444 + (n - 2176); else if (n < 2216) s = 1280 + (n - 2208); else if (n < 2220) s = 2056 + (n - 2216); else if (n < 2304) return nullptr; else s = 1800 + (n - 2304);
            return m.base + s; }
        case 4: return n < 384 ? m.base + n : nullptr;
        default: return n < 256 ? m.base + (n >> 6) * 128 + (n & 63) : m.base + ((n - 256) >> 6) * 128 + 64 + (n & 63);
    }
}
__device__ __forceinline__ void transpose_item(const WMap& m, int item, LAS float* scr, int lane) {
    const int nblk = m.N / 32, kb = item / nblk, nb = item % nblk, k0 = 64 * kb, n0 = 32 * nb;
    const float* cp = wmap_col(m, n0 + (lane & 31));
    const float cs = (m.kind == 2 && n0 >= 1280 && n0 < 1536) ? FOX_QS : 1.f;
    float wv[32];
#pragma unroll
    for (int i = 0; i < 32; ++i) { const int kk = 2 * i + (lane >> 5); wv[i] = cp ? cp[(size_t)(k0 + kk) * m.ld] : 0.f; }
#pragma unroll
    for (int i = 0; i < 32; ++i) { const int kk = 2 * i + (lane >> 5); float v = wv[i] * cs; if (cp && m.kscale) v *= m.kscale[k0 + kk]; scr[kk * 33 + (lane & 31)] = v; }
    LDS_WAIT();
    const int c = lane & 7;
#pragma unroll
    for (int j = 0; j < 4; ++j) { const int n = (lane >> 3) + 8 * j; const LAS float* s = scr + (8 * c) * 33 + n;
        u32x4 o; o.x = pk2(s[0 * 33], s[1 * 33]); o.y = pk2(s[2 * 33], s[3 * 33]); o.z = pk2(s[4 * 33], s[5 * 33]); o.w = pk2(s[6 * 33], s[7 * 33]);
        *(u32x4*)(m.dst + (size_t)(n0 + n) * m.K + k0 + 8 * c) = o; }
    LDS_WAIT();
}
__device__ __forceinline__ void convert_weights(const Ctx& c, int l) {
    const Params& p = *c.p; (void)p;
    LAS float* scr = (LAS float*)(c.lds + c.wid * 8704);
    const int gw = c.bid * 8 + c.wid, NGW = c.G * 8;
    constexpr int CNT[8] = {2816, 1408, 2816, 1408, 1280, 512, 64, 32};
    constexpr int TOTAL = 2816 + 1408 + 2816 + 1408 + 1280 + 512 + 64 + 32;
    for (int it = gw; it < TOTAL; it += NGW) {
        int r = it, mi = 0;
#pragma unroll
        for (int i = 0; i < 7; ++i) { if (mi == i && r >= CNT[i]) { r -= CNT[i]; mi = i + 1; } }
        WMap m;
        switch (mi) {
            case 0: m = WMap{INP(p, I_F1G) + (size_t)l * DM * DFF, INP(p, I_F1U) + (size_t)l * DM * DFF, nullptr, c.W<bf16_t>(WS_WGU1), DFF, DM, 2 * DFF, 1}; break;
            case 1: m = WMap{INP(p, I_F1D) + (size_t)l * DFF * DM, nullptr, nullptr, c.W<bf16_t>(WS_WD1), DM, DFF, DM, 0}; break;
            case 2: m = WMap{INP(p, I_F2G) + (size_t)l * DM * DFF, INP(p, I_F2U) + (size_t)l * DM * DFF, nullptr, c.W<bf16_t>(WS_WGU2), DFF, DM, 2 * DFF, 1}; break;
            case 3: m = WMap{INP(p, I_F2D) + (size_t)l * DFF * DM, nullptr, nullptr, c.W<bf16_t>(WS_WD2), DM, DFF, DM, 0}; break;
            case 4: m = WMap{INP(p, I_WIN) + (size_t)l * DM * NIN, nullptr, nullptr, c.W<bf16_t>(WS_WIN), NIN, DM, 2560, 2}; break;
            case 5: m = WMap{INP(p, I_WOUT) + (size_t)l * DM * DM, nullptr, nullptr, c.W<bf16_t>(WS_WOUT), DM, DM, DM, 0}; break;
            case 6: m = WMap{INP(p, I_WUQ) + (size_t)l * 256 * 384, nullptr, INP(p, I_QNG) + l * 256, c.W<bf16_t>(WS_WUQ), 384, 256, 512, 4}; break;
            default: m = WMap{INP(p, I_WUKV) + (size_t)l * 128 * 512, nullptr, INP(p, I_KVNG) + l * 128, c.W<bf16_t>(WS_WUKV), 512, 128, 512, 5}; break;
        }
        transpose_item(m, r, scr, c.lane);
    }
}

__device__ __forceinline__ void ln_rows(const Ctx& c, const float* g, const float* bta, bf16_t* hb, int nrows) {
    const int gw = c.bid * 8 + c.wid, NGW = c.G * 8;
    f32x4 gv[4], bv[4];
#pragma unroll
    for (int j = 0; j < 4; ++j) { gv[j] = ((const f32x4*)g)[c.lane + 64 * j]; bv[j] = ((const f32x4*)bta)[c.lane + 64 * j]; }
    for (int row = gw; row < nrows; row += NGW) {
        f32x4* xr = (f32x4*)c.hrow(row) + c.lane;
        if (row + NGW < nrows) __builtin_prefetch((const void*)((const f32x4*)c.hrow(row + NGW) + c.lane), 0, 0);
        f32x4 v[4]; float s = 0.f;
#pragma unroll
        for (int j = 0; j < 4; ++j) { v[j] = xr[64 * j]; s += (v[j][0] + v[j][1]) + (v[j][2] + v[j][3]); }
        const float mean = wave_sum(s) * (1.f / DM); float s2 = 0.f;
#pragma unroll
        for (int j = 0; j < 4; ++j) { v[j] = v[j] - mean; s2 += (v[j][0] * v[j][0] + v[j][1] * v[j][1]) + (v[j][2] * v[j][2] + v[j][3] * v[j][3]); }
        const float rstd = 1.f / sqrtf(wave_sum(s2) * (1.f / DM) + EPS);
#pragma unroll
        for (int j = 0; j < 4; ++j) {
            const f32x4 o = v[j] * rstd * gv[j] + bv[j];
            xr[64 * j] = o;
            if (hb) { u32x2 w; w.x = pk2(o[0], o[1]); w.y = pk2(o[2], o[3]); *((u32x2*)(hb + (size_t)row * DM) + c.lane + 64 * j) = w; }
        }
    }
}

template <int DQK, bool BIAS>
__device__ __forceinline__ void attn_item(const Ctx& c, const bf16_t* Qb, const bf16_t* Kb, int ld, const bf16_t* Vb, int ldv, const float* bias, bf16_t* mix, int ocol, int b, int j) {
    constexpr int KP = DQK + 8, NS = DQK / 32, KCH = DQK / 8, KPT = 128 * KCH / 512;
    constexpr int VP = 136;
    constexpr int KB_BYTES = 128 * KP * 2, VB_BYTES = 64 * VP * 2;
    LAS unsigned char* lds = c.lds;
    const int tid = c.tid, lane = c.lane, w = c.wid, fr = lane & 15, fq = lane >> 4;
    const int nq = j == 0 ? 16 : 128, ntiles = j + 1;
    const int qpos0 = j == 0 ? 0 : NMETA + 128 * (j - 1);
    const bool active = (16 * w) < nq;
    bf16x8 qf[NS];
    if (active) {
        const bf16_t* qp = Qb + (size_t)row_of(b, qpos0 + 16 * w + fr) * ld + fq * 8;
#pragma unroll
        for (int s = 0; s < NS; ++s) qf[s] = *(const bf16x8*)(qp + s * 32);
    }
    u32x4 kreg[KPT], vreg[2]; float breg = 0.f;
    auto load_tile = [&](int t) {
        const int pos0 = t == 0 ? 0 : NMETA + 128 * (t - 1), nk = t == 0 ? 16 : 128;
#pragma unroll
        for (int i = 0; i < KPT; ++i) { const int q = tid + 512 * i, r = q / KCH, cc = q % KCH;
            kreg[i] = (u32x4){0u, 0u, 0u, 0u};
            if (r < nk) kreg[i] = *(const u32x4*)(Kb + (size_t)row_of(b, pos0 + r) * ld + cc * 8); }
#pragma unroll
        for (int i = 0; i < 2; ++i) { const int q = tid + 512 * i, r = q & 127, cc = q >> 7;
            vreg[i] = (u32x4){0u, 0u, 0u, 0u};
            if (r < nk) vreg[i] = *(const u32x4*)(Vb + (size_t)row_of(b, pos0 + r) * ldv + cc * 8); }
        if (BIAS && tid < 128) breg = tid < nk ? bias[pos0 + tid] : 0.f;
    };
    auto store_tile = [&](int buf) {
        LAS unsigned char* kb = lds + buf * KB_BYTES; LAS unsigned char* vb = lds + 2 * KB_BYTES + buf * VB_BYTES;
#pragma unroll
        for (int i = 0; i < KPT; ++i) { const int q = tid + 512 * i, r = q / KCH, cc = q % KCH; *(LAS u32x4*)(kb + (r * KP + cc * 8) * 2) = kreg[i]; }
#pragma unroll
        for (int i = 0; i < 2; ++i) { const int q = tid + 512 * i, r = q & 127, cc = q >> 7; LAS bf16_t* vp = (LAS bf16_t*)vb + (cc * 8) * VP + r;
            vp[0] = (bf16_t)(vreg[i].x & 0xffffu); vp[VP] = (bf16_t)(vreg[i].x >> 16); vp[2 * VP] = (bf16_t)(vreg[i].y & 0xffffu); vp[3 * VP] = (bf16_t)(vreg[i].y >> 16);
            vp[4 * VP] = (bf16_t)(vreg[i].z & 0xffffu); vp[5 * VP] = (bf16_t)(vreg[i].z >> 16); vp[6 * VP] = (bf16_t)(vreg[i].w & 0xffffu); vp[7 * VP] = (bf16_t)(vreg[i].w >> 16); }
        if (BIAS && tid < 128) ((LAS float*)(lds + 2 * KB_BYTES + 2 * VB_BYTES))[buf * 128 + tid] = breg;
    };
    float m_run = -INFINITY, l_run = 0.f;
    f32x4 o[4];
#pragma unroll
    for (int dg = 0; dg < 4; ++dg) o[dg] = zero_acc();
    const int q_local = 16 * w + fr;
    auto compute = [&](int buf, auto ngc, int mode  ) {
        constexpr int NG = decltype(ngc)::value;
        const LAS unsigned char* kb = lds + buf * KB_BYTES; const LAS unsigned char* vb = lds + 2 * KB_BYTES + buf * VB_BYTES;
        const LAS float* bb = (const LAS float*)(lds + 2 * KB_BYTES + 2 * VB_BYTES) + buf * 128;
        f32x4 sacc[NG];
#pragma unroll
        for (int g = 0; g < NG; ++g) {
            sacc[g] = BIAS ? *(const LAS f32x4*)(bb + 16 * g + 4 * fq) : zero_acc();
#pragma unroll
            for (int s = 0; s < NS; ++s) { const bf16x8 kf = *(const LAS bf16x8*)(kb + ((16 * g + fr) * KP + s * 32 + fq * 8) * 2);
                sacc[g] = __builtin_amdgcn_mfma_f32_16x16x32_bf16(kf, qf[s], sacc[g], 0, 0, 0); }
        }
        if (mode != 0) {
            const int lim = mode == 1 ? q_local : 15;
#pragma unroll
            for (int g = 0; g < NG; ++g)
#pragma unroll
                for (int e = 0; e < 4; ++e) if (16 * g + 4 * fq + e > lim) sacc[g][e] = -INFINITY;
        }
        float mx = sacc[0][0];
#pragma unroll
        for (int g = 0; g < NG; ++g)
#pragma unroll
            for (int e = 0; e < 4; ++e) mx = fmaxf(mx, sacc[g][e]);
        mx = fmaxf(mx, __shfl_xor(mx, 16)); mx = fmaxf(mx, __shfl_xor(mx, 32));
        const float m_new = fmaxf(m_run, mx);
        const float alpha = fast_exp2(m_run - m_new);
        m_run = m_new;
        float ps = 0.f;
#pragma unroll
        for (int g = 0; g < NG; ++g)
#pragma unroll
            for (int e = 0; e < 4; ++e) { const float pv = fast_exp2(sacc[g][e] - m_new); sacc[g][e] = pv; ps += pv; }
        l_run = l_run * alpha + ps;
#pragma unroll
        for (int dg = 0; dg < 4; ++dg) o[dg] = o[dg] * alpha;
#pragma unroll
        for (int sl = 0; sl < NG / 2; ++sl) {
            f32x4 pa = sacc[2 * sl], pb = sacc[2 * sl + 1];
            u32x4 pw; pw.x = pk2(pa[0], pa[1]); pw.y = pk2(pa[2], pa[3]); pw.z = pk2(pb[0], pb[1]); pw.w = pk2(pb[2], pb[3]);
            const bf16x8 pf = __builtin_bit_cast(bf16x8, pw);
#pragma unroll
            for (int dg = 0; dg < 4; ++dg) {
                const LAS unsigned char* vp = vb + ((16 * dg + fr) * VP + 32 * sl + 4 * fq) * 2;
                const u32x2 lo = *(const LAS u32x2*)vp, hi = *(const LAS u32x2*)(vp + 32);
                const u32x4 vv = {lo.x, lo.y, hi.x, hi.y};
                o[dg] = __builtin_amdgcn_mfma_f32_16x16x32_bf16(__builtin_bit_cast(bf16x8, vv), pf, o[dg], 0, 0, 0);
            }
        }
    };
    load_tile(0); store_tile(0); __syncthreads();
    for (int t = 0; t < ntiles; ++t) {
        if (t + 1 < ntiles) load_tile(t + 1);
        if (active) {
            if (t == 0) compute(0, std::integral_constant<int, 2>{}, j == 0 ? 1 : 2);
            else compute(t & 1, std::integral_constant<int, 8>{}, t == j ? 1 : 0);
        }
        if (t + 1 < ntiles) store_tile((t + 1) & 1);
        __syncthreads();
    }
#ifdef CK_TEST
    if (active && (j > 0 || b == 0)) {
        const int qpos = qpos0 + q_local; const int row = row_of(b, qpos);
        bf16_t* op = mix + (size_t)row * DM + ocol + 4 * fq;
#pragma unroll
        for (int dg = 0; dg < 4; ++dg) { float v[4];
#pragma unroll
            for (int e = 0; e < 4; ++e) { const int d = 16 * dg + 4 * fq + e; v[e] = bf2f(Vb[(size_t)row * ldv + d]); }
            u32x2 wv; wv.x = pk2(v[0], v[1]); wv.y = pk2(v[2], v[3]); *(u32x2*)(op + 16 * dg) = wv; }
    }
    if (0) {
        float l = l_run; l += __shfl_xor(l, 16); l += __shfl_xor(l, 32);
#else
    if (active && (j > 0 || b == 0)) {
        float l = l_run; l += __shfl_xor(l, 16); l += __shfl_xor(l, 32);
#endif
        const float rl = 1.f / l;
        bf16_t* op = mix + (size_t)row_of(b, qpos0 + q_local) * DM + ocol + 4 * fq;
#pragma unroll
        for (int dg = 0; dg < 4; ++dg) { u32x2 wv; wv.x = pk2(o[dg][0] * rl, o[dg][1] * rl); wv.y = pk2(o[dg][2] * rl, o[dg][3] * rl); *(u32x2*)(op + 16 * dg) = wv; }
    }
}

__device__ __forceinline__ void ssd_item_seq(const Ctx& c, int b, int h, int ph, int l) {
    const Params& p = *c.p; (void)p;
    constexpr int O_B = 0, O_C = 32768, O_X = 65536, O_Z = 73728, O_DT = 81920;
    LAS unsigned char* lds = c.lds;
    const int tid = c.tid, g = h >> 2, pl = tid >> 4, l16 = tid & 15, ns = 4 * l16;
    const bf16_t* Cn = c.W<bf16_t>(WS_CN) + g * 64; const bf16_t* Bn = c.W<bf16_t>(WS_BN) + g * 64;
    const bf16_t* XC = c.W<bf16_t>(WS_XC) + h * 64 + 32 * ph; const bf16_t* Z = c.W<bf16_t>(WS_Z) + h * 64 + 32 * ph; const float* dtv = c.W<float>(WS_DTV) + h;
    bf16_t* mix = c.W<bf16_t>(WS_HB) + h * 64 + 32 * ph + pl;
    const float Ah = -__expf(INP(p, I_ALOG)[l * 8 + h]) * LOG2E, Dh = INP(p, I_DSKIP)[l * 8 + h];
    u32x4 rB[2], rC[2], rX, rZ; float rD = 0.f;
    auto load_chunk = [&](int ch) {
        const int pos0 = ch == 0 ? 0 : NMETA + 128 * (ch - 1), nv = ch == 0 ? 16 : 128;
#pragma unroll
        for (int i = 0; i < 2; ++i) { const int q = tid + 512 * i, r = q >> 3, cc = q & 7; rB[i] = (u32x4){0u, 0u, 0u, 0u}; rC[i] = rB[i];
            if (r < nv) { const size_t ro = (size_t)row_of(b, pos0 + r) * 128 + cc * 8; rB[i] = *(const u32x4*)(Bn + ro); rC[i] = *(const u32x4*)(Cn + ro); } }
        { const int r = tid >> 2, cc = tid & 3; rX = (u32x4){0u, 0u, 0u, 0u}; rZ = rX;
            if (r < nv) { const size_t ro = (size_t)row_of(b, pos0 + r) * 512 + cc * 8; rX = *(const u32x4*)(XC + ro); rZ = *(const u32x4*)(Z + ro); } }
        if (tid < 128) rD = tid < nv ? dtv[(size_t)row_of(b, pos0 + tid) * 8] : 0.f;
    };
    auto store_chunk = [&]() {
#pragma unroll
        for (int i = 0; i < 2; ++i) { const int q = tid + 512 * i;
            LAS f32x4* db = (LAS f32x4*)(lds + O_B + q * 32); LAS f32x4* dc = (LAS f32x4*)(lds + O_C + q * 32);
            db[0] = (f32x4){bf2f(rB[i].x & 0xffffu), bf2f(rB[i].x >> 16), bf2f(rB[i].y & 0xffffu), bf2f(rB[i].y >> 16)}; db[1] = (f32x4){bf2f(rB[i].z & 0xffffu), bf2f(rB[i].z >> 16), bf2f(rB[i].w & 0xffffu), bf2f(rB[i].w >> 16)};
            dc[0] = (f32x4){bf2f(rC[i].x & 0xffffu), bf2f(rC[i].x >> 16), bf2f(rC[i].y & 0xffffu), bf2f(rC[i].y >> 16)}; dc[1] = (f32x4){bf2f(rC[i].z & 0xffffu), bf2f(rC[i].z >> 16), bf2f(rC[i].w & 0xffffu), bf2f(rC[i].w >> 16)}; }
        *(LAS u32x4*)(lds + O_X + tid * 16) = rX; *(LAS u32x4*)(lds + O_Z + tid * 16) = rZ;
        if (tid < 128) ((LAS float*)(lds + O_DT))[tid] = rD;
    };
    f32x4 S = {0.f, 0.f, 0.f, 0.f};
#define DPP_ADD(y, ctrl) y += __builtin_bit_cast(float, __builtin_amdgcn_update_dpp(0, __builtin_bit_cast(int, y), ctrl, 0xf, 0xf, true))
    load_chunk(0); store_chunk(); __syncthreads();
    for (int ch = 0; ch < 17; ++ch) {
        if (ch + 1 < 17) load_chunk(ch + 1);
        const int pos0 = ch == 0 ? 0 : NMETA + 128 * (ch - 1), nv = ch == 0 ? 16 : 128;
        const bool wr = (ch > 0 || b == 0);
        for (int i0 = 0; i0 < nv; i0 += 16) {
            float ykeep = 0.f;
#pragma unroll
            for (int k = 0; k < 16; ++k) {
                const int i = i0 + k;
                const float dt = ((const LAS float*)(lds + O_DT))[i];
                const float x = bf2f(((const LAS bf16_t*)(lds + O_X))[i * 32 + pl]);
                const f32x4 bv = *(const LAS f32x4*)(lds + O_B + (i * 64 + ns) * 4), cv = *(const LAS f32x4*)(lds + O_C + (i * 64 + ns) * 4);
                const float a = fast_exp2(dt * Ah), dx = dt * x;
                S = S * a + bv * dx;
                const f32x4 cs = cv * S;
                float y = (cs[0] + cs[1]) + (cs[2] + cs[3]);
                DPP_ADD(y, 0xB1); DPP_ADD(y, 0x4E); DPP_ADD(y, 0x141); DPP_ADD(y, 0x140);
                ykeep = (l16 == k) ? y : ykeep;
            }
            if (wr) { const int t = i0 + l16;
                const float x = bf2f(((const LAS bf16_t*)(lds + O_X))[t * 32 + pl]), zz = bf2f(((const LAS bf16_t*)(lds + O_Z))[t * 32 + pl]);
                const float o = (ykeep + Dh * x) * silu_f(zz); mix[(size_t)row_of(b, pos0 + t) * DM] = (bf16_t)(pk2(o, 0.f) & 0xffffu); }
        }
        __syncthreads();
        if (ch + 1 < 17) store_chunk();
        __syncthreads();
    }
#undef DPP_ADD
}

#define XB_TMO      128
#define XB_XCNT(j)  (256  + 64 * (j))
#define XB_XSUB(j)  (1280 + 64 * (j))
#define XB_XGEN(j)  (2304 + 64 * (j))
#define XB_TOP      3328
#define XB_TOPGEN   3392
#define XCD_BAR_WORDS 3456
#define XB_SPIN_CAP (1u << 18)

__device__ __forceinline__ unsigned xb_ld(unsigned* p)              { return __hip_atomic_load(p, __ATOMIC_RELAXED, __HIP_MEMORY_SCOPE_AGENT); }
__device__ __forceinline__ unsigned xb_add(unsigned* p, unsigned v) { return __hip_atomic_fetch_add(p, v, __ATOMIC_RELAXED, __HIP_MEMORY_SCOPE_AGENT); }
__device__ __forceinline__ unsigned xb_xcc_id() { return (unsigned)__builtin_amdgcn_s_getreg((3 << 11) | 20) & 0xFu; }
#define XB_SPIN(cond, bar) do { unsigned _sp = 0; while (cond) { __builtin_amdgcn_s_sleep(1); \
    if ((++_sp & 255u) == 0u) { if (xb_ld(&(bar)[XB_TMO])) break; if (_sp > XB_SPIN_CAP) { atomicAdd(&(bar)[XB_TMO], 1u); break; } } } } while (0)

struct XcdBarrier {
    unsigned* bar; unsigned x;
    volatile LAS unsigned* st;
};

__device__ __forceinline__ XcdBarrier xcd_barrier_post(unsigned* bar, volatile LAS unsigned* st) {
    XcdBarrier b; b.bar = bar; b.x = xb_xcc_id(); b.st = st;
    if (threadIdx.x == 0) (void)xb_add(&bar[XB_XCNT(b.x)], 1u);
    return b;
}
__device__ __forceinline__ void xcd_barrier_complete(unsigned* bar, unsigned x, unsigned& nloc, unsigned& nx) {
    const unsigned G = gridDim.x * gridDim.y * gridDim.z;
    unsigned sum, cnt, mine, sp = 0u;
    for (;;) {
        sum = 0u; cnt = 0u; mine = 0u;
#pragma unroll
        for (unsigned j = 0; j < 16; ++j) { const unsigned c = xb_ld(&bar[XB_XCNT(j)]); sum += c; cnt += (c > 0u) ? 1u : 0u; mine = (j == x) ? c : mine; }
        if (sum == G) break;
        __builtin_amdgcn_s_sleep(1);
        if ((++sp & 255u) == 0u) { if (xb_ld(&bar[XB_TMO])) break; if (sp > XB_SPIN_CAP) { atomicAdd(&bar[XB_TMO], 1u); break; } }
    }
    nloc = mine > 0u ? mine : 1u; nx = cnt > 0u ? cnt : 1u;
}

__device__ __forceinline__ void xcd_barrier(const XcdBarrier& b) {
    asm volatile("s_waitcnt vmcnt(0)" ::: "memory");
    __syncthreads();
    if (threadIdx.x == 0) {
        unsigned* bar = b.bar;
        __builtin_amdgcn_s_waitcnt(0);
        unsigned nloc = b.st[0], nx = b.st[1];
        if (nloc == 0u) { xcd_barrier_complete(bar, b.x, nloc, nx); b.st[0] = nloc; b.st[1] = nx; }
        const unsigned old = xb_add(&bar[XB_XSUB(b.x)], 1u);
        const unsigned gen = old / nloc;
        if (old + 1u == (gen + 1u) * nloc) {
            __builtin_amdgcn_fence(__ATOMIC_RELEASE, "agent");
            asm volatile("s_waitcnt vmcnt(0)" ::: "memory");
            const unsigned og = xb_add(&bar[XB_TOP], 1u);
            const unsigned tg = og / nx;
            if (og + 1u == (tg + 1u) * nx) xb_add(&bar[XB_TOPGEN], 1u);
            else XB_SPIN(xb_ld(&bar[XB_TOPGEN]) == tg, bar);
            __builtin_amdgcn_fence(__ATOMIC_ACQUIRE, "agent");
            xb_add(&bar[XB_XGEN(b.x)], 1u);
            asm volatile("s_waitcnt vmcnt(0)" ::: "memory");
        } else {
            XB_SPIN(xb_ld(&bar[XB_XGEN(b.x)]) == gen, bar);
            __builtin_amdgcn_fence(__ATOMIC_ACQUIRE, "agent");
            asm volatile("s_waitcnt vmcnt(0)" ::: "memory");
        }
    }
    __syncthreads();
}

enum { EK_SWIGLU = 0, EK_RESID = 1, EK_IN = 2, EK_UQ = 3, EK_UKV = 4 };
struct EpiAny {
    int kind; unsigned char* ws; float* hmain; float s; const float* base;
    __device__ __forceinline__ bool perm() const { return kind != EK_UQ; }
    __device__ __forceinline__ void operator()(const Acc& acc, const Unit& u, int wr, int wc, int fr, int fq) const {
        if (kind == EK_SWIGLU) { EpiSwiglu{(bf16_t*)(ws + WS_ACT)}(acc, u, wr, wc, fr, fq); }
        else if (kind == EK_RESID) { EpiResid{hmain, s, base}(acc, u, wr, wc, fr, fq); }
        else if (kind == EK_IN) { EpiIn{ws}(acc, u, wr, wc, fr, fq); }
        else if (kind == EK_UQ) { EpiUq{UqStore{(bf16_t*)(ws + WS_QM), (const float*)(ws + WS_SSQQ), (const f32x2*)(ws + WS_ROPE)}}(acc, u, wr, wc, fr, fq); }
        else { EpiUk{UkStore{(bf16_t*)(ws + WS_KM), (const float*)(ws + WS_SSQKV)}, (bf16_t*)(ws + WS_VM)}(acc, u, wr, wc, fr, fq); }
    }
};
struct GDesc { const bf16_t* A; const bf16_t* Bt; int M, N, K, kind, coff; float s; };
struct MDesc { const bf16_t* A; const bf16_t* Bt; int lda, ldb, K, n0, off2, kind; float s; };
enum { MK_SWIGLU = 0, MK_RESID = 1, MK_IN = 2, MK_UQ = 3, MK_UKV = 4 };

template <int MASK>
__global__ void __launch_bounds__(512, 2) mk_fwd(Params prm) {
    extern __shared__ __attribute__((aligned(16))) unsigned char lds_raw[];
    const Params& p = prm;
#if MK_LAUNCHES == 1
    volatile LAS unsigned* xb_st = (volatile LAS unsigned*)((LAS unsigned char*)lds_raw + 133632);
    if (threadIdx.x < 2) xb_st[threadIdx.x] = 0u;
    __syncthreads();
    const XcdBarrier xbar = xcd_barrier_post((unsigned*)(prm.ws + WS_BAR), xb_st);
#endif
#ifdef NO_LOOP
    { int ph = p.ph_lo;
#else
    for (int ph = p.ph_lo; ph < p.ph_hi; ++ph) {
#endif
        Ctx c;
#define FRESH() do { unsigned char* ws_ = prm.ws; float* out_ = prm.out; int tid_ = threadIdx.x; unsigned ldsb = 0u; \
          asm volatile("" : "+s"(ws_), "+s"(out_), "+v"(tid_), "+s"(ldsb)); \
          c.lds = (LAS unsigned char*)lds_raw + ldsb; \
          c.tid = tid_; c.lane = tid_ & 63; c.wid = __builtin_amdgcn_readfirstlane(tid_ >> 6); c.bid = blockIdx.x; c.G = gridDim.x; \
          c.p = &prm; c.ws = ws_; c.hmain = out_; c.hmeta = (float*)(ws_ + WS_HMETA); } while (0)
        FRESH();
        const int l = ph == 0 ? 0 : (ph - 1) / 12, k = ph == 0 ? -1 : (ph - 1) % 12;
        const bool lastffn = (l == 1 && k >= 9);
#ifdef DUP_K
        const int nrep = (k == DUP_K) ? 2 : 1;
#else
        const int nrep = 1;
#endif
        for (int rep = 0; rep < nrep; ++rep) {
        if (rep > 0) { cg::this_grid().sync(); if (blockIdx.x == 0 && threadIdx.x == 0) ((unsigned*)(prm.ws + WS_CTL))[0] = 0u; cg::this_grid().sync(); FRESH(); }

        if (EN(1)) {
#ifdef SSD_T6
            const int ng = (k == 0 || k == 9 || k == 1 || k == 10 || k == 7 || k == 3) ? 1 : 0;
#else
            const int ng = (k == 0 || k == 9 || k == 1 || k == 10 || k == 7 || k == 3) ? 1 : (k == 4 ? 2 : 0);
#endif
            for (int gi = 0; gi < ng; ++gi) {
                FRESH();
                GDesc d;
                bf16_t* HB = c.W<bf16_t>(WS_HB); bf16_t* ACT = c.W<bf16_t>(WS_ACT);
                if (k == 0 || k == 9) d = GDesc{HB, c.W<bf16_t>(k == 0 ? WS_WGU1 : WS_WGU2), RMAIN, 2 * DFF, DM, EK_SWIGLU, 0, 0.f};
                else if (k == 1 || k == 10) d = GDesc{ACT, c.W<bf16_t>(k == 1 ? WS_WD1 : WS_WD2), RMAIN, DM, DFF, EK_RESID, 0, 0.5f};
                else if (k == 7) d = GDesc{HB, c.W<bf16_t>(WS_WOUT), RMAIN, DM, DM, EK_RESID, 0, 1.f};
                else if (k == 3) d = GDesc{HB, c.W<bf16_t>(WS_WIN), RMAIN, 2560, DM, EK_IN, 0, 0.f};
                else if (gi == 0) d = GDesc{c.W<bf16_t>(WS_CQ), c.W<bf16_t>(WS_WUQ), RMAIN, 512, 256, EK_UQ, 0, 0.f};
                else d = GDesc{c.W<bf16_t>(WS_CKV), c.W<bf16_t>(WS_WUKV), RMAIN, 512, 128, EK_UKV, 128, 0.f};
                pg8::Gemm g{d.A, d.Bt, d.M, d.N, d.K}; pg8::StaticOrder S; S.init(d.M, d.N, c.G, (c.bid + c.G - d.coff) % c.G);
                const bool firstffn = (l == 0 && k == 1);
                EpiAny E{d.kind, c.ws, c.hmain, d.s, firstffn ? INP(p, I_X) : (const float*)c.hmain};
                pg8::gemm_phase<EpiAny, pg8::StaticOrder, true>(c.lds, g, S, E);
            }
        }
        if (EN(2)) {
            FRESH();
            const int nmu = lastffn ? 0 : (k == 0 || k == 9) ? DFF / 16 : (k == 1 || k == 10 || k == 7) ? DM / 32 : k == 3 ? 80 : k == 4 ? 12 + 16 : 0;
            for (int mu = (2 * c.bid >= c.G) ? c.G - 1 - c.bid : nmu; mu < nmu; mu += c.G / 2) {
                FRESH();
                bf16_t* HB = c.W<bf16_t>(WS_HB); bf16_t* ACT = c.W<bf16_t>(WS_ACT);
                MDesc m;
                if (k == 0 || k == 9) { const int a0 = 16 * mu; m = MDesc{HB + (size_t)RMAIN * DM, c.W<bf16_t>(k == 0 ? WS_WGU1 : WS_WGU2), DM, DM, DM, 256 * (a0 >> 7) + (a0 & 127), 128, MK_SWIGLU, 0.f}; }
                else if (k == 1 || k == 10) m = MDesc{ACT + (size_t)RMAIN * DFF, c.W<bf16_t>(k == 1 ? WS_WD1 : WS_WD2), DFF, DFF, DFF, 32 * mu, 16, MK_RESID, 0.5f};
                else if (k == 7) m = MDesc{HB + (size_t)RMAIN * DM, c.W<bf16_t>(WS_WOUT), DM, DM, DM, 32 * mu, 16, MK_RESID, 1.f};
                else if (k == 3) m = MDesc{HB + (size_t)RMAIN * DM, c.W<bf16_t>(WS_WIN), DM, DM, DM, 32 * mu, 16, MK_IN, 0.f};
                else if (mu < 12) m = MDesc{c.W<bf16_t>(WS_CQ) + (size_t)RMAIN * 256, c.W<bf16_t>(WS_WUQ), 256, 256, 256, 32 * mu, 16, MK_UQ, 0.f};
                else m = MDesc{c.W<bf16_t>(WS_CKV) + (size_t)RMAIN * 128, c.W<bf16_t>(WS_WUKV), 128, 128, 128, 32 * (mu - 12), 16, MK_UKV, 0.f};
                unsigned char* ws = c.ws; float* hm = c.hmeta; const int lane = c.lane;
                meta_unit(c, m.A, m.lda, m.Bt, m.ldb, m.K, m.n0, m.off2, [&](int r, int ca, f32x4 va, int cb, f32x4 vb) {
                    if (m.kind == MK_SWIGLU) {
                        const int a0 = 128 * (m.n0 >> 8) + (m.n0 & 127);
                        u32x2 w; w.x = pk2(silu_f(va[0]) * vb[0], silu_f(va[1]) * vb[1]); w.y = pk2(silu_f(va[2]) * vb[2], silu_f(va[3]) * vb[3]);
                        *(u32x2*)((bf16_t*)(ws + WS_ACT) + (size_t)(RMAIN + r) * DFF + a0 + (ca - m.n0)) = w;
                    } else if (m.kind == MK_RESID) {
                        const float* bm = (l == 0 && k == 1) ? INP(p, I_META) : (const float*)hm;
                        *(f32x4*)(hm + (size_t)r * DM + ca) = *(const f32x4*)(bm + (size_t)r * DM + ca) * ALPHA + va * m.s;
                        *(f32x4*)(hm + (size_t)r * DM + cb) = *(const f32x4*)(bm + (size_t)r * DM + cb) * ALPHA + vb * m.s;
                    } else if (m.kind == MK_IN) {
                        InStore st{(bf16_t*)(ws + WS_Z), (bf16_t*)(ws + WS_XBC), (bf16_t*)(ws + WS_FQ), (bf16_t*)(ws + WS_FK), (bf16_t*)(ws + WS_CQ), (bf16_t*)(ws + WS_CKV), (float*)(ws + WS_SMALL), (bf16_t*)(ws + WS_FV)};
                        st.store4(RMAIN + r, ca, va); st.store4(RMAIN + r, cb, vb);
                        if (ca >= 1792 && ca < 2176) {
                            float sq = va[0] * va[0] + va[1] * va[1] + va[2] * va[2] + va[3] * va[3] + vb[0] * vb[0] + vb[1] * vb[1] + vb[2] * vb[2] + vb[3] * vb[3];
                            sq += __shfl_xor(sq, 16); sq += __shfl_xor(sq, 32);
                            if ((lane >> 4) == 0) atomicAdd((float*)(ws + (ca < 2048 ? WS_SSQQ : WS_SSQKV)) + (size_t)(RMAIN + r) * 4, sq);
                        }
                    } else if (m.kind == MK_UQ) {
                        UqStore{(bf16_t*)(ws + WS_QM), (const float*)(ws + WS_SSQQ), (const f32x2*)(ws + WS_ROPE)}.store(RMAIN + r, m.n0, ca - m.n0, va, vb);
                    } else {
                        if (ca < 256) { UkStore uks{(bf16_t*)(ws + WS_KM), (const float*)(ws + WS_SSQKV)}; uks.store4(RMAIN + r, ca, va); uks.store4(RMAIN + r, cb, vb); }
                        else { const float sc = __builtin_amdgcn_rsqf(ssq4((const float*)(ws + WS_SSQKV), RMAIN + r) * (1.f / 128.f) + EPS); bf16_t* vm = (bf16_t*)(ws + WS_VM) + (size_t)(RMAIN + r) * 256;
                            u32x2 w; w.x = pk2(va[0] * sc, va[1] * sc); w.y = pk2(va[2] * sc, va[3] * sc); *(u32x2*)(vm + (ca - 256)) = w;
                            w.x = pk2(vb[0] * sc, vb[1] * sc); w.y = pk2(vb[2] * sc, vb[3] * sc); *(u32x2*)(vm + (cb - 256)) = w; }
                    }
                });
            }
        }
        FRESH();
        const int gtid = c.bid * 512 + c.tid, GT = c.G * 512;
        bf16_t* HB = c.W<bf16_t>(WS_HB);
        unsigned* ctl = c.W<unsigned>(WS_CTL);
        LAS int* s_item = (LAS int*)(c.lds + 133120);
        if (EN(0) && ph == 0) {
            convert_weights(c, 0);
            f32x2* rope = c.W<f32x2>(WS_ROPE);
            for (int i = gtid; i < LTOT * 16; i += GT) {
                const int pos = i >> 4, fi = i & 15;
                const float inv = exp2f(-(float)fi * (13.287712379549449f / 16.f));
                const float ang = (float)pos * inv;
                float t = ang * 0.15915494309189535f; t = t - rintf(t);
                rope[i] = (f32x2){__builtin_amdgcn_cosf(t), __builtin_amdgcn_sinf(t)};
            }
            for (int i = gtid; i < RT * 256; i += GT) {
                const int row = i >> 8, c4 = i & 255;
                const f32x4 v = row < RMAIN ? ((const f32x4*)INP(p, I_X))[(size_t)row * 256 + c4] : ((const f32x4*)INP(p, I_META))[(size_t)(row - RMAIN) * 256 + c4];
                u32x2 w; w.x = pk2(v[0], v[1]); w.y = pk2(v[2], v[3]); ((u32x2*)(HB + (size_t)row * DM))[c4] = w;
            }
        } else if (EN(3) && (k == 2 || k == 8 || k == 11)) {
            const int gi = k == 2 ? I_LN1G : k == 8 ? I_LN2G : I_LN3G;
            const bool last = (l == 1 && k == 11);
            ln_rows(c, INP(p, gi) + l * DM, INP(p, gi + 1) + l * DM, last ? nullptr : HB, last ? RMAIN : RT);
            if (k == 2) {
                float* z1 = c.W<float>(WS_SSQQ); float* z2 = c.W<float>(WS_SSQKV); float* z3 = c.W<float>(WS_SSQS);
                for (int i = gtid; i < NMETA * 4; i += GT) { z1[(size_t)RMAIN * 4 + i] = 0.f; z2[(size_t)RMAIN * 4 + i] = 0.f; } (void)z3;
                if (gtid == 0) ctl[0] = 0u;
            }
            if (k == 11 && l == 0) convert_weights(c, 1);
        } else if (EN(8) && k == 4) {
            bf16_t* Km = c.W<bf16_t>(WS_KM);
#ifndef SKIP_P5
            {
                const bf16_t* XBC = c.W<bf16_t>(WS_XBC); bf16_t* XC = c.W<bf16_t>(WS_XC); bf16_t* BN = c.W<bf16_t>(WS_BN); bf16_t* CN = c.W<bf16_t>(WS_CN);
                bf16_t* XT = c.W<bf16_t>(WS_XT); bf16_t* BT = c.W<bf16_t>(WS_BT);
                const float* cw = INP(p, I_CONVW) + (size_t)l * 4 * 768; const float* cbias = INP(p, I_CONVB) + (size_t)l * 768;
                for (int un0 = c.bid; un0 < NB * 258; un0 += 2 * c.G) {
                    const int un1 = un0 + c.G; const bool has1 = un1 < NB * 258;
                    const int b0 = un0 / 258, p00 = (un0 % 258) * 8, b1 = has1 ? un1 / 258 : b0, p01 = has1 ? (un1 % 258) * 8 : p00;
                    for (int ch = c.tid; ch < 768; ch += 512) {
                        const float w0 = cw[ch], w1 = cw[768 + ch], w2 = cw[1536 + ch], w3 = cw[2304 + ch], bs = cbias[ch];
                        bf16_t xa[11], xb[11];
#pragma unroll
                        for (int i = 0; i < 11; ++i) { const int pa = p00 - 3 + i, pb = p01 - 3 + i;
                            xa[i] = XBC[(size_t)row_of(b0, pa < 0 ? 0 : pa) * 768 + ch]; xb[i] = XBC[(size_t)row_of(b1, pb < 0 ? 0 : pb) * 768 + ch]; }
#pragma unroll
                        for (int u = 0; u < 2; ++u) {
                            if (u == 1 && !has1) break;
                            const int b = u ? b1 : b0, p0 = u ? p01 : p00;
                            float xin[11];
#pragma unroll
                            for (int i = 0; i < 11; ++i) xin[i] = (p0 - 3 + i) >= 0 ? bf2f(u ? xb[i] : xa[i]) : 0.f;
                            float o[8];
#pragma unroll
                            for (int i = 0; i < 8; ++i) o[i] = silu_f(bs + w0 * xin[i] + w1 * xin[i + 1] + w2 * xin[i + 2] + w3 * xin[i + 3]);
                            u32x4 pw; pw.x = pk2(o[0], o[1]); pw.y = pk2(o[2], o[3]); pw.z = pk2(o[4], o[5]); pw.w = pk2(o[6], o[7]);
                            if (ch < 512) *(u32x4*)(XT + ((size_t)b * 512 + ch) * LP + p0) = pw;
                            else if (ch < 640) *(u32x4*)(BT + ((size_t)b * 128 + ch - 512) * LP + p0) = pw;
                        }
                    }
                }
            }
#endif
#ifndef SKIP_P6
            {
                const bf16_t* XBC = c.W<bf16_t>(WS_XBC); bf16_t* XC = c.W<bf16_t>(WS_XC); bf16_t* BN = c.W<bf16_t>(WS_BN); bf16_t* CN = c.W<bf16_t>(WS_CN);
                const float* cw = INP(p, I_CONVW) + (size_t)l * 4 * 768; const float* cbias = INP(p, I_CONVB) + (size_t)l * 768;
                auto nat_finish = [&](int row, int cg8, int pos, const u32x4 (&xv4)[4]) {
                    float acc8[8];
                    { const f32x4 b0 = *(const f32x4*)(cbias + cg8), b1 = *(const f32x4*)(cbias + cg8 + 4);
                      acc8[0] = b0[0]; acc8[1] = b0[1]; acc8[2] = b0[2]; acc8[3] = b0[3]; acc8[4] = b1[0]; acc8[5] = b1[1]; acc8[6] = b1[2]; acc8[7] = b1[3]; }
#pragma unroll
                    for (int kk = 0; kk < 4; ++kk) {
                        if (pos - 3 + kk >= 0) {
                            const u32x4 xv = xv4[kk];
                            const f32x4 w0 = *(const f32x4*)(cw + kk * 768 + cg8), w1 = *(const f32x4*)(cw + kk * 768 + cg8 + 4);
                            acc8[0] += w0[0] * bf2f(xv.x & 0xffffu); acc8[1] += w0[1] * bf2f(xv.x >> 16); acc8[2] += w0[2] * bf2f(xv.y & 0xffffu); acc8[3] += w0[3] * bf2f(xv.y >> 16);
                            acc8[4] += w1[0] * bf2f(xv.z & 0xffffu); acc8[5] += w1[1] * bf2f(xv.z >> 16); acc8[6] += w1[2] * bf2f(xv.w & 0xffffu); acc8[7] += w1[3] * bf2f(xv.w >> 16);
                        }
                    }
                    u32x4 o; o.x = pk2(silu_f(acc8[0]), silu_f(acc8[1])); o.y = pk2(silu_f(acc8[2]), silu_f(acc8[3])); o.z = pk2(silu_f(acc8[4]), silu_f(acc8[5])); o.w = pk2(silu_f(acc8[6]), silu_f(acc8[7]));
                    if (cg8 < 512) *(u32x4*)(XC + (size_t)row * 512 + cg8) = o; else if (cg8 < 640) *(u32x4*)(BN + (size_t)row * 128 + cg8 - 512) = o; else *(u32x4*)(CN + (size_t)row * 128 + cg8 - 640) = o;
                };
                for (int ia = gtid; ia < RT * 96; ia += 2 * GT) {
                    const int ib0 = ia + GT; const bool hb = ib0 < RT * 96; const int ib = hb ? ib0 : ia;
                    const int rowa = ia / 96, cga = (ia % 96) * 8, posa = pos_of_row(rowa), ba = rowa < RMAIN ? rowa >> 11 : 0;
                    const int rowb = ib / 96, cgb = (ib % 96) * 8, posb = pos_of_row(rowb), bb = rowb < RMAIN ? rowb >> 11 : 0;
                    u32x4 xa[4], xb[4];
#pragma unroll
                    for (int kk = 0; kk < 4; ++kk) { const int pa = posa - 3 + kk, pb = posb - 3 + kk;
                        xa[kk] = *(const u32x4*)(XBC + (size_t)row_of(ba, pa < 0 ? 0 : pa) * 768 + cga); xb[kk] = *(const u32x4*)(XBC + (size_t)row_of(bb, pb < 0 ? 0 : pb) * 768 + cgb); }
                    nat_finish(rowa, cga, posa, xa);
                    if (hb) nat_finish(rowb, cgb, posb, xb);
                }
            }
            {
                const float* SM = c.W<float>(WS_SMALL); float* dtv = c.W<float>(WS_DTV); const float* dtb = INP(p, I_DTB) + l * 8;
                for (int i = gtid; i < RT * 8; i += GT) { const int row = i >> 3, hh = i & 7; const float x = SM[(size_t)row * 64 + 32 + hh] + dtb[hh];
                    dtv[i] = fmaxf(x, 0.f) + log1pf(__expf(-fabsf(x))); }
                const f32x2* rp = c.W<f32x2>(WS_ROPE);
                for (int i = gtid; i < RT * 16; i += GT) { const int row = i >> 4, fi = i & 15; const f32x2 cs = rp[(size_t)pos_of_row(row) * 16 + fi];
                    const float x1 = SM[(size_t)row * 64 + fi], x2 = SM[(size_t)row * 64 + 16 + fi];
                    const bf16_t o1 = (bf16_t)(pk2(x1 * cs.x - x2 * cs.y, 0.f) & 0xffffu), o2 = (bf16_t)(pk2(x2 * cs.x + x1 * cs.y, 0.f) & 0xffffu);
#pragma unroll
                    for (int hh = 0; hh < 4; ++hh) { Km[(size_t)row * 384 + hh * 96 + 64 + fi] = o1; Km[(size_t)row * 384 + hh * 96 + 80 + fi] = o2; } }
                float* cbv = c.W<float>(WS_CB); const float* ffb = INP(p, I_FFB) + l * 4;
                const int gw = c.bid * 8 + c.wid;
                if (gw < 32) {
                    const int b = gw >> 2, hh = gw & 3; const float fb = ffb[hh];
                    float v[33]; float s = 0.f;
#pragma unroll
                    for (int i = 0; i < 33; ++i) { const int pos = c.lane * 33 + i; float lf = 0.f;
                        if (pos < LTOT) { const float x = SM[(size_t)row_of(b, pos) * 64 + 40 + hh] + fb; lf = fminf(x, 0.f) - log1pf(__expf(-fabsf(x))); }
                        s += lf; v[i] = s; }
                    float t = s;
#pragma unroll
                    for (int o = 1; o < 64; o <<= 1) { const float u = __shfl_up(t, o); if (c.lane >= o) t += u; }
                    const float base = t - s;
#pragma unroll
                    for (int i = 0; i < 33; ++i) { const int pos = c.lane * 33 + i; if (pos < LTOT) cbv[(size_t)(b * 4 + hh) * LP + pos] = -(base + v[i]) * LOG2E; }
                }
            }
#endif
        } else if (EN(6) && k == 5) {
            bf16_t* MIX = HB;
            const bf16_t* FQ = c.W<bf16_t>(WS_FQ); const bf16_t* FK = c.W<bf16_t>(WS_FK); const bf16_t* FV = c.W<bf16_t>(WS_FV); const float* cbv = c.W<float>(WS_CB);
            const bf16_t* Qm = c.W<bf16_t>(WS_QM); const bf16_t* Km = c.W<bf16_t>(WS_KM); const bf16_t* Vm = c.W<bf16_t>(WS_VM);
            int qn = 0; (void)qn;
            for (;;) {
                __syncthreads();
#ifdef STATIC_Q
                if (c.tid == 0) { *s_item = c.bid + qn * c.G; } ++qn;
#else
                if (c.tid == 0) *s_item = (int)atomicAdd(ctl, 1u);
#endif
                __syncthreads();
                int it = *s_item; asm volatile("" : "+v"(it)); it = __builtin_amdgcn_readfirstlane(it);
                if (it >= 128 + 1024 + 8) break;
                FRESH();
#ifndef SKIP_SSD
#ifdef DUP_K
                if (it < 128 && rep > 0) continue;
#endif
                if (it < 128) { ssd_item_seq(c, it >> 4, (it >> 1) & 7, it & 1, l); continue; }
#endif
                int j, mixer, bh;
                if (it < 128 + 1024) { const int r = it - 128; j = 16 - (r >> 6); mixer = (r >> 5) & 1; bh = r & 31; }
                else { const int r = it - 128 - 1024; j = 0; mixer = r >> 2; bh = r & 3; }
                const int b = bh >> 2, hh = bh & 3;
#ifndef SKIP_FOX
                if (mixer == 0) attn_item<64, true>(c, FQ + hh * 64, FK + hh * 64, 256, FV + hh * 64, 256, cbv + (size_t)(b * 4 + hh) * LP, MIX, 512 + hh * 64, b, j);
#endif
#ifndef SKIP_MLA
                if (mixer == 1) attn_item<96, false>(c, Qm + hh * 96, Km + hh * 96, 384, Vm + hh * 64, 256, nullptr, MIX, 768 + hh * 64, b, j);
#endif
            }
        } else if (EN(7) && k == 6) {
            bf16_t* MIX = HB; const float* ng = INP(p, I_SNG) + l * 512;
            for (int i = gtid; i < RT * 64; i += GT) {
                const int row = i >> 6, c8 = (i & 63) * 8;
                u32x4* q = (u32x4*)(MIX + (size_t)row * DM + c8); const u32x4 v = *q;
                const float t0 = bf2f(v.x & 0xffffu), t1 = bf2f(v.x >> 16), t2 = bf2f(v.y & 0xffffu), t3 = bf2f(v.y >> 16), t4 = bf2f(v.z & 0xffffu), t5 = bf2f(v.z >> 16), t6 = bf2f(v.w & 0xffffu), t7 = bf2f(v.w >> 16);
                float ss = ((t0 * t0 + t1 * t1) + (t2 * t2 + t3 * t3)) + ((t4 * t4 + t5 * t5) + (t6 * t6 + t7 * t7));
                ss += __shfl_xor(ss, 1); ss += __shfl_xor(ss, 2); ss += __shfl_xor(ss, 4); ss += __shfl_xor(ss, 8); ss += __shfl_xor(ss, 16);
                const float rs = __builtin_amdgcn_rsqf(ss * (1.f / 256.f) + EPS);
                const f32x4 g0 = *(const f32x4*)(ng + c8), g1 = *(const f32x4*)(ng + c8 + 4);
                u32x4 o;
                o.x = pk2(t0 * rs * g0[0], t1 * rs * g0[1]); o.y = pk2(t2 * rs * g0[2], t3 * rs * g0[3]); o.z = pk2(t4 * rs * g1[0], t5 * rs * g1[1]); o.w = pk2(t6 * rs * g1[2], t7 * rs * g1[3]);
                *q = o;
            }
        }
        }
#if MK_LAUNCHES == 1
        if (ph + 1 < p.ph_hi) {
            if (ph == 0) cg::this_grid().sync();
            else xcd_barrier(xbar);
        }
#endif
    }
}

extern "C" void kernel_launch(void* const* d_in, const int* in_sizes, int n_in, void* d_out, int out_size, void* d_ws, size_t ws_size, hipStream_t stream) {
    static int grid = 0;
    if (grid == 0) {
        if (n_in != 27 || ws_size < WS_END) { fprintf(stderr, "kernel_launch: unexpected inputs (n_in %d, ws %zu, need %zu)\n", n_in, ws_size, (size_t)WS_END); grid = -1; return; }
        int dev = 0, cus = 0, per_cu = 0;
        (void)hipGetDevice(&dev); (void)hipDeviceGetAttribute(&cus, hipDeviceAttributeMultiprocessorCount, dev);
        const void* fn = (const void*)mk_fwd<PH_MASK>;
        if (hipFuncSetAttribute(fn, hipFuncAttributeMaxDynamicSharedMemorySize, LDS_BYTES) != hipSuccess) { fprintf(stderr, "kernel_launch: hipFuncSetAttribute failed\n"); grid = -1; return; }
        if (hipOccupancyMaxActiveBlocksPerMultiprocessor(&per_cu, fn, 512, LDS_BYTES) != hipSuccess || per_cu < 1) { fprintf(stderr, "kernel_launch: occupancy query failed (%d)\n", per_cu); (void)hipGetLastError(); per_cu = 1; }
        grid = cus * per_cu;
    }
    if (grid < 0) return;
    if (hipMemsetAsync((char*)d_ws + WS_BAR, 0, 16384, stream) != hipSuccess) { fprintf(stderr, "kernel_launch: hipMemsetAsync failed\n"); return; }
    Params prm{};
    for (int i = 0; i < 27; ++i) prm.in[i] = (const float*)d_in[i];
    prm.out = (float*)d_out; prm.ws = (unsigned char*)d_ws;
#ifndef NPH_LIMIT
#define NPH_LIMIT 25
#endif
    constexpr int NPH = NPH_LIMIT;
#if MK_LAUNCHES == 1
    prm.ph_lo = 0; prm.ph_hi = NPH;
    void* args[] = {&prm};
    hipError_t e = hipLaunchCooperativeKernel((const void*)mk_fwd<PH_MASK>, dim3(grid), dim3(512), args, LDS_BYTES, stream);
    if (e != hipSuccess) fprintf(stderr, "cooperative launch failed: %s (grid %d)\n", hipGetErrorString(e), grid);
#else
    for (int ph = 0; ph < NPH; ++ph) { prm.ph_lo = ph; prm.ph_hi = ph + 1; hipLaunchKernelGGL(mk_fwd<PH_MASK>, dim3(grid), dim3(512), LDS_BYTES, stream, prm); }
#endif
}
```

```cpp
#include <hip/hip_runtime.h>
#include <hip/hip_cooperative_groups.h>
#include <cstdio>
#include <cstdint>
#include <type_traits>
namespace cg = cooperative_groups;

#ifndef PH_MASK
#define PH_MASK 0x1ff
#endif
#define EN(n) ((MASK >> (n)) & 1)


#ifndef MK_LAUNCHES
#define MK_LAUNCHES 1
#endif
#if MK_LAUNCHES != 1
#define NO_LOOP 1
#endif

#define LAS __attribute__((address_space(3)))
typedef unsigned short bf16_t;
typedef short bf16x8 __attribute__((ext_vector_type(8)));
typedef short s16x4 __attribute__((ext_vector_type(4)));
typedef float f32x4 __attribute__((ext_vector_type(4)));
typedef float f32x2 __attribute__((ext_vector_type(2)));
typedef unsigned u32x4 __attribute__((ext_vector_type(4)));
typedef unsigned u32x2 __attribute__((ext_vector_type(2)));

constexpr int NB = 8, SEQ = 2048, NMETA = 16, LTOT = 2064, DM = 1024, DFF = 2816;
constexpr int RMAIN = NB * SEQ;
constexpr int RT = RMAIN + NMETA;
constexpr int LP = 2080;
constexpr int NIN = 2476;
constexpr float ALPHA = 1.4142135623730951f;
constexpr float EPS = 1e-5f;
constexpr float LOG2E = 1.4426950408889634f;
constexpr float FOX_QS = 0.125f * LOG2E;
constexpr float MLA_QS = 0.10206207261596575f * LOG2E;

constexpr size_t al256(size_t x) { return (x + 255) & ~(size_t)255; }
constexpr size_t WS_CTL = 0;
constexpr size_t WS_BAR = 4096;
constexpr size_t WS_HMETA = 4096 + 16384;
constexpr size_t WS_ROPE = al256(WS_HMETA + (size_t)NMETA * DM * 4);
constexpr size_t WS_SSQQ = al256(WS_ROPE + (size_t)LTOT * 16 * 8);
constexpr size_t WS_SSQKV = al256(WS_SSQQ + (size_t)RT * 16);
constexpr size_t WS_SSQS = al256(WS_SSQKV + (size_t)RT * 16);
constexpr size_t WS_DTV = al256(WS_SSQS + (size_t)RT * 8 * 4);
constexpr size_t WS_CB = al256(WS_DTV + (size_t)RT * 8 * 4);
constexpr size_t WS_SMALL = al256(WS_CB + (size_t)NB * 4 * LP * 4);
constexpr size_t WS_WGU1 = al256(WS_SMALL + (size_t)RT * 64 * 4);
constexpr size_t WS_WD1 = al256(WS_WGU1 + (size_t)2 * DFF * DM * 2);
constexpr size_t WS_WGU2 = al256(WS_WD1 + (size_t)DM * DFF * 2);
constexpr size_t WS_WD2 = al256(WS_WGU2 + (size_t)2 * DFF * DM * 2);
constexpr size_t WS_WIN = al256(WS_WD2 + (size_t)DM * DFF * 2);
constexpr size_t WS_WOUT = al256(WS_WIN + (size_t)2560 * DM * 2);
constexpr size_t WS_WUQ = al256(WS_WOUT + (size_t)DM * DM * 2);
constexpr size_t WS_WUKV = al256(WS_WUQ + (size_t)512 * 256 * 2);
constexpr size_t WS_HB = al256(WS_WUKV + (size_t)512 * 128 * 2);
constexpr size_t WS_ACT = al256(WS_HB + (size_t)RT * DM * 2);
constexpr size_t WS_Z = WS_ACT;
constexpr size_t WS_XBC = al256(WS_Z + (size_t)RT * 512 * 2);
constexpr size_t WS_FQ = al256(WS_XBC + (size_t)RT * 768 * 2);
constexpr size_t WS_FK = al256(WS_FQ + (size_t)RT * 256 * 2);
constexpr size_t WS_CQ = al256(WS_FK + (size_t)RT * 256 * 2);
constexpr size_t WS_CKV = al256(WS_CQ + (size_t)RT * 256 * 2);
constexpr size_t WS_ACT_END = al256(WS_ACT + (size_t)RT * DFF * 2);
constexpr size_t WS_FV = al256(WS_CKV + (size_t)RT * 128 * 2);
static_assert(WS_FV + (size_t)RT * 256 * 2 <= WS_ACT_END, "mixer buffers overflow the act alias");
constexpr size_t WS_XC = WS_ACT_END;
constexpr size_t WS_BN = al256(WS_XC + (size_t)RT * 512 * 2);
constexpr size_t WS_CN = al256(WS_BN + (size_t)RT * 128 * 2);
constexpr size_t WS_XT = al256(WS_CN + (size_t)RT * 128 * 2);
constexpr size_t WS_BT = al256(WS_XT + (size_t)NB * 512 * LP * 2);
constexpr size_t WS_QM = al256(WS_BT + (size_t)NB * 128 * LP * 2);
constexpr size_t WS_KM = al256(WS_QM + (size_t)RT * 384 * 2);
constexpr size_t WS_VM = al256(WS_KM + (size_t)RT * 384 * 2);
constexpr size_t WS_END = al256(WS_VM + (size_t)RT * 256 * 2);
static_assert(WS_END <= (size_t)268435456, "workspace map exceeds 256 MiB");

constexpr int LDS_BYTES = 135168;

__device__ __forceinline__ float bf2f(unsigned v) { return __uint_as_float(v << 16); }
__device__ __forceinline__ unsigned pk2(float lo, float hi) { unsigned r; asm("v_cvt_pk_bf16_f32 %0, %1, %2" : "=v"(r) : "v"(lo), "v"(hi)); return r; }
__device__ __forceinline__ float fast_exp2(float x) { return __builtin_amdgcn_exp2f(x); }
__device__ __forceinline__ float silu_f(float x) { return x * __builtin_amdgcn_rcpf(1.f + fast_exp2(-x * LOG2E)); }
__device__ __forceinline__ int row_of(int b, int pos) { return pos < NMETA ? RMAIN + pos : b * SEQ + pos - NMETA; }
__device__ __forceinline__ int pos_of_row(int row) { return row < RMAIN ? NMETA + (row & (SEQ - 1)) : row - RMAIN; }
#define LDS_WAIT() asm volatile("s_waitcnt lgkmcnt(0)" ::: "memory")
__device__ __forceinline__ float ssq4(const float* p, int row) { const f32x4 q = *(const f32x4*)(p + (size_t)row * 4); return (q[0] + q[1]) + (q[2] + q[3]); }
__device__ __forceinline__ f32x4 zero_acc() { f32x4 z = {0.f, 0.f, 0.f, 0.f}; asm volatile("" : "+v"(z)); return z; }
__device__ __forceinline__ float wave_sum(float v) {
#define WS_DPP(ctrl) v += __builtin_bit_cast(float, __builtin_amdgcn_update_dpp(0, __builtin_bit_cast(int, v), ctrl, 0xf, 0xf, true))
    WS_DPP(0xB1); WS_DPP(0x4E); WS_DPP(0x141); WS_DPP(0x140);
#undef WS_DPP
    v += __shfl_xor(v, 16); v += __shfl_xor(v, 32);
    return v;
}

namespace pg8 {
constexpr int BM = 256, BK = 64, HALF = 128, HTB = HALF * BK * 2, STAGE_BYTES = 8 * HTB, NXCD = 8, WGM = 8;
__host__ __device__ __forceinline__ int lds_byte(int r, int c) { const int st = (r >> 4) * 2 + (c >> 5), rr = r & 15, cc = c & 31, ob = rr * 64 + cc * 2; return st * 1024 + (ob ^ (((ob >> 9) & 1) << 5)); }
__host__ __device__ __forceinline__ void stage_rc(int b, int& R, int& C) { const int st = b / 1024, sb = b % 1024, swz = sb ^ (((sb >> 9) & 1) << 5); R = (st >> 1) * 16 + swz / 64; C = (st & 1) * 32 + (swz % 64) / 2; }
__host__ __device__ __forceinline__ int perm32(int rho) { const int n = rho >> 4, i = rho & 15; return 8 * (i >> 2) + 4 * n + (i & 3); }
struct Unit { int pm, pn; };
struct Gemm { const bf16_t* A; const bf16_t* Bt; int M, N, K; };
struct StaticOrder {
    int nM, nN, nwg, G, c;
    __device__ void init(int M, int N, int G_, int c_) { nM = M / BM; nN = N / BM; nwg = nM * nN; G = __builtin_amdgcn_readfirstlane(G_); c = __builtin_amdgcn_readfirstlane(c_); }
    __device__ bool next(int i, Unit& u) const {
        const long L = (long)i * G + c; if (L >= nwg) return false;
        int wgid = (int)L; { const int q = nwg / NXCD, r = nwg % NXCD, xcd = wgid % NXCD, off = wgid / NXCD; wgid = (xcd < r ? xcd * (q + 1) : r * (q + 1) + (xcd - r) * q) + off; }
        const int nig = WGM * nN, gid = wgid / nig, fm = gid * WGM, gsz = (nM - fm) < WGM ? (nM - fm) : WGM;
        u.pm = __builtin_amdgcn_readfirstlane(fm + ((wgid % nig) % gsz)); u.pn = __builtin_amdgcn_readfirstlane((wgid % nig) / gsz); return true;
    }
    __device__ __forceinline__ void a_ready(const Unit&) const {}
    __device__ __forceinline__ void done(const Unit&) const {}
};
template <class Epi, class Sched, bool ALIGN_EPI>
__device__ __forceinline__ void gemm_phase(LAS unsigned char* lds, const Gemm g, const Sched& S, const Epi& E) {
    const int tid = threadIdx.x, wid = __builtin_amdgcn_readfirstlane(tid >> 6), lane = tid & 63, wr = wid >> 2, wc = wid & 3, fr = lane & 15, fq = lane >> 4;
    int K = g.K; asm volatile("" : "+s"(K));
    const int nt = K / BK;
    unsigned voffA[2], voffB[2];
#pragma unroll
    for (int i = 0; i < 2; ++i) { int R, C; stage_rc(tid * 16 + i * 8192, R, C); const int Rb = E.perm() ? ((R & ~31) + perm32(R & 31)) : R;
        voffA[i] = (unsigned)(R * K + C) * 2u; voffB[i] = (unsigned)(Rb * K + C) * 2u; }
    const size_t kstep = (size_t)(BK * 2);
    const size_t hstep = (size_t)HALF * K * 2;
    const size_t tstep = 2 * hstep;
    const unsigned ldsw = (unsigned)wid * 1024u;
    const int aoff = lds_byte(wr * 64 + fr, fq * 8), boff = lds_byte(wc * 32 + fr, fq * 8);
#define PG8_SA(b, h) (((b) * 2 + (h)) * HTB)
#define PG8_SB(b, h) ((4 + (b) * 2 + (h)) * HTB)
#define PG8_STAGE(bufoff, gbase, voff) do { _Pragma("unroll") for (int _i = 0; _i < 2; ++_i) \
        __builtin_amdgcn_global_load_lds((const unsigned*)((const char*)(gbase) + (voff)[_i]), (LAS unsigned*)(lds + (bufoff) + ldsw + _i * 8192), 16, 0, 0); } while (0)
#define PG8_LDA(dst, b, h) do { _Pragma("unroll") for (int m = 0; m < 4; ++m) _Pragma("unroll") for (int k = 0; k < 2; ++k) dst[m][k] = *(const LAS bf16x8*)(lds + PG8_SA(b, h) + aoff + m * 2048 + k * 1024); } while (0)
#define PG8_LDB(dst, b, h) do { _Pragma("unroll") for (int n = 0; n < 2; ++n) _Pragma("unroll") for (int k = 0; k < 2; ++k) dst[n][k] = *(const LAS bf16x8*)(lds + PG8_SB(b, h) + boff + n * 2048 + k * 1024); } while (0)
#define PG8_MMA(ai, bj, At, Bt) do { __builtin_amdgcn_s_setprio(1); _Pragma("unroll") for (int m = 0; m < 4; ++m) _Pragma("unroll") for (int n = 0; n < 2; ++n) _Pragma("unroll") for (int k = 0; k < 2; ++k) \
        acc[ai][bj][m][n] = __builtin_amdgcn_mfma_f32_16x16x32_bf16(Bt[n][k], At[m][k], acc[ai][bj][m][n], 0, 0, 0); __builtin_amdgcn_s_setprio(0); } while (0)
#define PG8_WAIT_V(n) asm volatile("s_waitcnt vmcnt(" #n ")" ::: "memory")
#define PG8_WAIT_L(n) asm volatile("s_waitcnt lgkmcnt(" #n ")" ::: "memory")
#define PG8_BAR __builtin_amdgcn_s_barrier()
#define PG8_SCHED __builtin_amdgcn_sched_barrier(0)
    Unit cur, nxt; int ui = 0;
    if (!S.next(0, cur)) return;
    f32x4 acc[2][2][4][2];
#pragma unroll
    for (int a = 0; a < 2; ++a)
#pragma unroll
        for (int b = 0; b < 2; ++b)
#pragma unroll
            for (int m = 0; m < 4; ++m)
#pragma unroll
                for (int n = 0; n < 2; ++n) acc[a][b][m][n] = (f32x4){0.f, 0.f, 0.f, 0.f};
    bf16x8 At[4][2], B0[2][2], B1[2][2];
    const char* cA = (const char*)g.A + (size_t)cur.pm * tstep; const char* cB = (const char*)g.Bt + (size_t)cur.pn * tstep;
    PG8_STAGE(PG8_SB(0, 0), cB, voffB); PG8_STAGE(PG8_SB(0, 1), cB + hstep, voffB); PG8_STAGE(PG8_SA(0, 0), cA, voffA); PG8_STAGE(PG8_SA(0, 1), cA + hstep, voffA);
    if (wr == 1) PG8_BAR;
    PG8_WAIT_V(2); PG8_BAR;
    PG8_STAGE(PG8_SB(1, 0), cB + kstep, voffB); PG8_STAGE(PG8_SA(1, 0), cA + kstep, voffA); PG8_STAGE(PG8_SB(1, 1), cB + hstep + kstep, voffB);
    PG8_WAIT_V(6); PG8_BAR;
    for (;;) {
        const bool has_next = S.next(ui + 1, nxt);
        const char* nA = has_next ? (const char*)g.A + (size_t)nxt.pm * tstep : cA; const char* nB = has_next ? (const char*)g.Bt + (size_t)nxt.pn * tstep : cB;
        for (int t = 0; t < nt; t += 2) {
            const bool last = (t == nt - 2);
            const char* a1 = cA + (size_t)(t + 1) * kstep;
            const char* a2 = last ? nA : cA + (size_t)(t + 2) * kstep; const char* b2 = last ? nB : cB + (size_t)(t + 2) * kstep;
            const char* a3 = a2 + kstep; const char* b3 = b2 + kstep;
            PG8_LDB(B0, 0, 0); PG8_LDB(B1, 0, 1); PG8_SCHED; PG8_LDA(At, 0, 0); PG8_STAGE(PG8_SA(1, 1), a1 + hstep, voffA);
            PG8_WAIT_V(8); PG8_WAIT_L(0); PG8_BAR; PG8_MMA(0, 0, At, B0); PG8_MMA(0, 1, At, B1); PG8_BAR; PG8_SCHED;
            PG8_LDA(At, 0, 1); PG8_STAGE(PG8_SB(0, 0), b2, voffB); PG8_STAGE(PG8_SB(0, 1), b2 + hstep, voffB); PG8_STAGE(PG8_SA(0, 0), a2, voffA);
            PG8_WAIT_V(8); PG8_WAIT_L(0); PG8_BAR; PG8_MMA(1, 0, At, B0); PG8_MMA(1, 1, At, B1); PG8_BAR; PG8_SCHED;
            PG8_LDB(B0, 1, 0); PG8_LDB(B1, 1, 1); PG8_SCHED; PG8_LDA(At, 1, 0); PG8_STAGE(PG8_SA(0, 1), a2 + hstep, voffA);
            PG8_WAIT_V(8); PG8_WAIT_L(0); PG8_BAR; PG8_MMA(0, 0, At, B0); PG8_MMA(0, 1, At, B1); PG8_BAR; PG8_SCHED;
            PG8_LDA(At, 1, 1); PG8_STAGE(PG8_SB(1, 0), b3, voffB); PG8_STAGE(PG8_SB(1, 1), b3 + hstep, voffB); PG8_STAGE(PG8_SA(1, 0), a3, voffA);
            PG8_WAIT_V(8); PG8_WAIT_L(0); PG8_BAR; PG8_MMA(1, 0, At, B0); PG8_MMA(1, 1, At, B1); PG8_BAR; PG8_SCHED;
        }
        if constexpr (ALIGN_EPI) { if (wr == 0) PG8_BAR; }
        { int pm_ = cur.pm, pn_ = cur.pn, t_ = tid; asm volatile("" : "+s"(pm_), "+s"(pn_), "+v"(t_));
          const int l_ = t_ & 63, w_ = __builtin_amdgcn_readfirstlane(t_ >> 6); Unit cu; cu.pm = pm_; cu.pn = pn_;
          E(acc, cu, w_ >> 2, w_ & 3, l_ & 15, l_ >> 4); }
        if (!has_next) break;
#pragma unroll
        for (int a = 0; a < 2; ++a)
#pragma unroll
            for (int b = 0; b < 2; ++b)
#pragma unroll
                for (int m = 0; m < 4; ++m)
#pragma unroll
                    for (int n = 0; n < 2; ++n) acc[a][b][m][n] = (f32x4){0.f, 0.f, 0.f, 0.f};
        cur = nxt; cA = nA; cB = nB; ++ui;
        if constexpr (ALIGN_EPI) { if (wr == 1) PG8_BAR; }
    }
    PG8_WAIT_V(0);
    if constexpr (!ALIGN_EPI) { if (wr == 0) PG8_BAR; }
    PG8_BAR;
#undef PG8_SA
#undef PG8_SB
#undef PG8_STAGE
#undef PG8_LDA
#undef PG8_LDB
#undef PG8_MMA
#undef PG8_WAIT_V
#undef PG8_WAIT_L
#undef PG8_BAR
#undef PG8_SCHED
}
}
using pg8::Unit;
typedef f32x4 Acc[2][2][4][2];

struct Params { const float* in[27]; float* out; unsigned char* ws; int ph_lo, ph_hi; };
enum { I_X = 0, I_META, I_F1G, I_F1U, I_F1D, I_LN1G, I_LN1B, I_WIN, I_CONVW, I_CONVB, I_DTB, I_ALOG, I_DSKIP, I_SNG, I_FFB, I_QNG, I_WUQ, I_KVNG, I_WUKV, I_WOUT,
       I_LN2G, I_LN2B, I_F2G, I_F2U, I_F2D, I_LN3G, I_LN3B };

__device__ __forceinline__ const float* INP(const Params& p, int i) { asm volatile("" : "+s"(i)); return p.in[i]; }
struct Ctx {
    LAS unsigned char* lds; int tid, lane, wid, bid, G;
    const Params* p; unsigned char* ws;
    float* hmain; float* hmeta;
    template <class T> __device__ __forceinline__ T* W(size_t off) const { return (T*)(ws + off); }
    __device__ __forceinline__ float* hrow(int row) const { return row < RMAIN ? hmain + (size_t)row * DM : hmeta + (size_t)(row - RMAIN) * DM; }
};

template <class F>
__device__ __forceinline__ void meta_unit(const Ctx& c, const bf16_t* A, int lda, const bf16_t* Bt, int ldb, int K, int n0, int off2, const F& f) {
    const int fr = c.lane & 15, fq = c.lane >> 4;
    f32x4 a0 = zero_acc(), a1 = zero_acc();
    const int steps = K / 32;
    const bf16_t* ap = A + (size_t)fr * lda + fq * 8;
    const bf16_t* b0p = Bt + (size_t)(n0 + fr) * ldb + fq * 8;
    const bf16_t* b1p = Bt + (size_t)(n0 + off2 + fr) * ldb + fq * 8;
#pragma unroll 4
    for (int s = c.wid; s < steps; s += 8) {
        const bf16x8 av = *(const bf16x8*)(ap + s * 32);
        const bf16x8 b0 = *(const bf16x8*)(b0p + s * 32);
        const bf16x8 b1 = *(const bf16x8*)(b1p + s * 32);
        a0 = __builtin_amdgcn_mfma_f32_16x16x32_bf16(b0, av, a0, 0, 0, 0);
        a1 = __builtin_amdgcn_mfma_f32_16x16x32_bf16(b1, av, a1, 0, 0, 0);
    }
    LAS f32x4* red = (LAS f32x4*)c.lds;
    red[(c.wid * 2 + 0) * 64 + c.lane] = a0; red[(c.wid * 2 + 1) * 64 + c.lane] = a1;
    __syncthreads();
    if (c.wid == 0) {
        f32x4 s0 = red[c.lane], s1 = red[64 + c.lane];
#pragma unroll
        for (int w = 1; w < 8; ++w) { s0 += red[(w * 2) * 64 + c.lane]; s1 += red[(w * 2 + 1) * 64 + c.lane]; }
        f(fr, n0 + 4 * fq, s0, n0 + off2 + 4 * fq, s1);
    }
    __syncthreads();
}

struct EpiSwiglu {
    static constexpr bool PERM = true;
    bf16_t* act;
    __device__ __forceinline__ void operator()(const Acc& acc, const Unit& u, int wr, int wc, int fr, int fq) const {
        const int row0 = u.pm * 256 + wr * 64 + fr, col0 = u.pn * 128 + wc * 32 + 8 * fq;
#pragma unroll
        for (int ai = 0; ai < 2; ++ai)
#pragma unroll
            for (int m = 0; m < 4; ++m) {
                const f32x4 g0 = acc[ai][0][m][0], g1 = acc[ai][0][m][1], u0 = acc[ai][1][m][0], u1 = acc[ai][1][m][1];
                u32x4 w;
                w.x = pk2(silu_f(g0[0]) * u0[0], silu_f(g0[1]) * u0[1]); w.y = pk2(silu_f(g0[2]) * u0[2], silu_f(g0[3]) * u0[3]);
                w.z = pk2(silu_f(g1[0]) * u1[0], silu_f(g1[1]) * u1[1]); w.w = pk2(silu_f(g1[2]) * u1[2], silu_f(g1[3]) * u1[3]);
                *(u32x4*)(act + (size_t)(row0 + ai * 128 + m * 16) * DFF + col0) = w;
                asm volatile("" ::: "memory");
            }
    }
};
struct EpiResid {
    static constexpr bool PERM = true;
    float* h; float s; const float* base;
    __device__ __forceinline__ void operator()(const Acc& acc, const Unit& u, int wr, int wc, int fr, int fq) const {
        const int row0 = u.pm * 256 + wr * 64 + fr, col0 = u.pn * 256 + wc * 32 + 8 * fq;
#pragma unroll
        for (int ai = 0; ai < 2; ++ai)
#pragma unroll
            for (int m = 0; m < 4; ++m) {
                const size_t ro = (size_t)(row0 + ai * 128 + m * 16) * DM + col0;
                f32x4 b[2][2];
#pragma unroll
                for (int bj = 0; bj < 2; ++bj)
#pragma unroll
                    for (int n = 0; n < 2; ++n) b[bj][n] = *(const f32x4*)(base + ro + bj * 128 + n * 4);
#pragma unroll
                for (int bj = 0; bj < 2; ++bj)
#pragma unroll
                    for (int n = 0; n < 2; ++n) *(f32x4*)(h + ro + bj * 128 + n * 4) = b[bj][n] * ALPHA + acc[ai][bj][m][n] * s;
                if (m & 1) asm volatile("" ::: "memory");
            }
    }
};
struct InStore {
    bf16_t *Z, *XBC, *FQ, *FK, *CQ, *CKV; float* SMALL; bf16_t* FV;
    __device__ __forceinline__ void store4(int row, int c, f32x4 v) const {
        if (c < 2048) {
            bf16_t* dst;
            if (c < 512) dst = Z + (size_t)row * 512 + c;
            else if (c < 1280) dst = XBC + (size_t)row * 768 + (c - 512);
            else if (c < 1536) { dst = FQ + (size_t)row * 256 + (c - 1280); }
            else if (c < 1792) dst = FK + (size_t)row * 256 + (c - 1536);
            else dst = CQ + (size_t)row * 256 + (c - 1792);
            u32x2 w; w.x = pk2(v[0], v[1]); w.y = pk2(v[2], v[3]); *(u32x2*)dst = w;
        } else if (c < 2176) {
            u32x2 w; w.x = pk2(v[0], v[1]); w.y = pk2(v[2], v[3]); *(u32x2*)(CKV + (size_t)row * 128 + (c - 2048)) = w;
        } else if (c < 2240) {
            *(f32x4*)(SMALL + (size_t)row * 64 + (c - 2176)) = v;
        } else if (c >= 2304) {
            u32x2 w; w.x = pk2(v[0], v[1]); w.y = pk2(v[2], v[3]); *(u32x2*)(FV + (size_t)row * 256 + (c - 2304)) = w;
        }
    }
};
struct EpiIn {
    static constexpr bool PERM = true;
    unsigned char* ws;
    __device__ __forceinline__ void operator()(const Acc& acc, const Unit& u, int wr, int wc, int fr, int fq) const {
        const int pn = u.pn, row0 = u.pm * 256 + wr * 64 + fr, colw = wc * 32 + 8 * fq;
        if (pn != 8) {
            bf16_t* base; int pitch;
            if (pn < 2) { base = (bf16_t*)(ws + WS_Z) + pn * 256; pitch = 512; }
            else if (pn < 5) { base = (bf16_t*)(ws + WS_XBC) + (pn - 2) * 256; pitch = 768; }
            else if (pn == 5) { base = (bf16_t*)(ws + WS_FQ); pitch = 256; }
            else if (pn == 6) { base = (bf16_t*)(ws + WS_FK); pitch = 256; }
            else if (pn == 7) { base = (bf16_t*)(ws + WS_CQ); pitch = 256; }
            else { base = (bf16_t*)(ws + WS_FV); pitch = 256; }
            float* ssq = (float*)(ws + WS_SSQQ);
#pragma unroll
            for (int ai = 0; ai < 2; ++ai)
#pragma unroll
                for (int m = 0; m < 4; ++m) {
                    const int row = row0 + ai * 128 + m * 16;
                    bf16_t* rp = base + (size_t)row * pitch + colw;
                    float s = 0.f;
#pragma unroll
                    for (int bj = 0; bj < 2; ++bj) {
                        const f32x4 v0 = acc[ai][bj][m][0], v1 = acc[ai][bj][m][1];
                        u32x4 w; w.x = pk2(v0[0], v0[1]); w.y = pk2(v0[2], v0[3]); w.z = pk2(v1[0], v1[1]); w.w = pk2(v1[2], v1[3]);
                        *(u32x4*)(rp + bj * 128) = w;
                        s += v0[0] * v0[0] + v0[1] * v0[1] + v0[2] * v0[2] + v0[3] * v0[3] + v1[0] * v1[0] + v1[1] * v1[1] + v1[2] * v1[2] + v1[3] * v1[3];
                    }
                    if (pn == 7) { s += __shfl_xor(s, 16); s += __shfl_xor(s, 32); if (fq == 0) ssq[(size_t)row * 4 + wc] = s; }
                    asm volatile("" ::: "memory");
                }
        } else {
            bf16_t* ckv = (bf16_t*)(ws + WS_CKV); float* sm = (float*)(ws + WS_SMALL); float* ssq = (float*)(ws + WS_SSQKV);
#pragma unroll
            for (int ai = 0; ai < 2; ++ai)
#pragma unroll
                for (int m = 0; m < 4; ++m) {
                    const int row = row0 + ai * 128 + m * 16;
                    const f32x4 v0 = acc[ai][0][m][0], v1 = acc[ai][0][m][1];
                    u32x4 w; w.x = pk2(v0[0], v0[1]); w.y = pk2(v0[2], v0[3]); w.z = pk2(v1[0], v1[1]); w.w = pk2(v1[2], v1[3]);
                    *(u32x4*)(ckv + (size_t)row * 128 + colw) = w;
                    float s = v0[0] * v0[0] + v0[1] * v0[1] + v0[2] * v0[2] + v0[3] * v0[3] + v1[0] * v1[0] + v1[1] * v1[1] + v1[2] * v1[2] + v1[3] * v1[3];
                    s += __shfl_xor(s, 16); s += __shfl_xor(s, 32); if (fq == 0) ssq[(size_t)row * 4 + wc] = s;
                    if (wc < 2) { *(f32x4*)(sm + (size_t)row * 64 + colw) = acc[ai][1][m][0]; *(f32x4*)(sm + (size_t)row * 64 + colw + 4) = acc[ai][1][m][1]; }
                    asm volatile("" ::: "memory");
                }
        }
    }
};
struct UqStore {
    bf16_t* Qm; const float* ssq_q; const f32x2* rope;
    __device__ __forceinline__ void store(int row, int gb, int i0, f32x4 va, f32x4 vb) const {
        if (gb >= 384) return;
        const float sc = __builtin_amdgcn_rsqf(ssq4(ssq_q, row) * (1.f / 256.f) + EPS) * MLA_QS;
        va = va * sc; vb = vb * sc;
        if ((gb % 96) == 64) {
            const f32x2* rt = rope + (size_t)pos_of_row(row) * 16 + i0;
#pragma unroll
            for (int e = 0; e < 4; ++e) { const f32x2 cs = rt[e]; const float x1 = va[e], x2 = vb[e]; va[e] = x1 * cs.x - x2 * cs.y; vb[e] = x2 * cs.x + x1 * cs.y; }
        }
        u32x2 w; w.x = pk2(va[0], va[1]); w.y = pk2(va[2], va[3]); *(u32x2*)(Qm + (size_t)row * 384 + gb + i0) = w;
        w.x = pk2(vb[0], vb[1]); w.y = pk2(vb[2], vb[3]); *(u32x2*)(Qm + (size_t)row * 384 + gb + 16 + i0) = w;
    }
};
struct EpiUq {
    static constexpr bool PERM = false;
    UqStore st;
    __device__ __forceinline__ void operator()(const Acc& acc, const Unit& u, int wr, int wc, int fr, int fq) const {
        const int row0 = u.pm * 256 + wr * 64 + fr;
#pragma unroll
        for (int ai = 0; ai < 2; ++ai)
#pragma unroll
            for (int m = 0; m < 4; ++m)
                { for (int bj = 0; bj < 2; ++bj) st.store(row0 + ai * 128 + m * 16, u.pn * 256 + bj * 128 + wc * 32, 4 * fq, acc[ai][bj][m][0], acc[ai][bj][m][1]);
                  asm volatile("" ::: "memory"); }
    }
};
struct UkStore {
    bf16_t* Km; const float* ssq_kv;
    __device__ __forceinline__ void store4(int row, int c, f32x4 v) const {
        const float sc = __builtin_amdgcn_rsqf(ssq4(ssq_kv, row) * (1.f / 128.f) + EPS);
        u32x2 w; w.x = pk2(v[0] * sc, v[1] * sc); w.y = pk2(v[2] * sc, v[3] * sc);
        *(u32x2*)(Km + (size_t)row * 384 + (c >> 6) * 96 + (c & 63)) = w;
    }
};
struct EpiUk {
    static constexpr bool PERM = true;
    UkStore st; bf16_t* VtM;
    __device__ __forceinline__ void operator()(const Acc& acc, const Unit& u, int wr, int wc, int fr, int fq) const {
        const int row0 = u.pm * 256 + wr * 64 + fr, col0 = wc * 32 + 8 * fq;
        const bool isv = u.pn == 1;
        const int kc0 = isv ? col0 : (col0 >> 6) * 96 + (col0 & 63);
        bf16_t* dstb = isv ? VtM : st.Km; const int pitch = isv ? 256 : 384, bjoff = isv ? 128 : 192;
#pragma unroll
        for (int ai = 0; ai < 2; ++ai)
#pragma unroll
            for (int m = 0; m < 4; ++m) {
                const int row = row0 + ai * 128 + m * 16;
                const float sc = __builtin_amdgcn_rsqf(ssq4(st.ssq_kv, row) * (1.f / 128.f) + EPS);
                bf16_t* rp = dstb + (size_t)row * pitch + kc0;
#pragma unroll
                for (int bj = 0; bj < 2; ++bj) {
                    const f32x4 v0 = acc[ai][bj][m][0] * sc, v1 = acc[ai][bj][m][1] * sc;
                    u32x4 w; w.x = pk2(v0[0], v0[1]); w.y = pk2(v0[2], v0[3]); w.z = pk2(v1[0], v1[1]); w.w = pk2(v1[2], v1[3]);
                    *(u32x4*)(rp + bj * bjoff) = w;
                }
                asm volatile("" ::: "memory");
            }
    }
};

struct WMap { const float* base; const float* base2; const float* kscale; bf16_t* dst; int ld, K, N, kind; };
__device__ __forceinline__ const float* wmap_col(const WMap& m, int n) {
    switch (m.kind) {
        case 0: return m.base + n;
        case 1: { const int t = n >> 8, w = n & 255; return w < 128 ? m.base + 128 * t + w : m.base2 + 128 * t + (w - 128); }
        case 2: {
            int s;
            if (n < 1280) s = n; else if (n < 1536) s = 1288 + (n - 1280); else if (n < 1792) s = 1544 + (n - 1536); else if (n < 2048) s = 2060 + (n - 1792);
            else if (n < 2176) s = 2316 + (n - 2048); else if (n < 2208) s = 2444 + (n - 2176); else if (n < 2216) s = 1280 + (n - 2208); else if (n < 2220) s = 2056 + (n - 2216); else if (n < 2304) return nullptr; else s = 1800 + (n - 2304);
            return m.base + s; }
        case 4: return n < 384 ? m.base + n : nullptr;
        default: return n < 256 ? m.base + (n >> 6) * 128 + (n & 63) : m.base + ((n - 256) >> 6) * 128 + 64 + (n & 63);
    }
}
__device__ __forceinline__ void transpose_item(const WMap& m, int item, LAS float* scr, int lane) {
    const int nblk = m.N / 32, kb = item / nblk, nb = item % nblk, k0 = 64 * kb, n0 = 32 * nb;
    const float* cp = wmap_col(m, n0 + (lane & 31));
    const float cs = (m.kind == 2 && n0 >= 1280 && n0 < 1536) ? FOX_QS : 1.f;
    float wv[32];
#pragma unroll
    for (int i = 0; i < 32; ++i) { const int kk = 2 * i + (lane >> 5); wv[i] = cp ? cp[(size_t)(k0 + kk) * m.ld] : 0.f; }
#pragma unroll
    for (int i = 0; i < 32; ++i) { const int kk = 2 * i + (lane >> 5); float v = wv[i] * cs; if (cp && m.kscale) v *= m.kscale[k0 + kk]; scr[kk * 33 + (lane & 31)] = v; }
    LDS_WAIT();
    const int c = lane & 7;
#pragma unroll
    for (int j = 0; j < 4; ++j) { const int n = (lane >> 3) + 8 * j; const LAS float* s = scr + (8 * c) * 33 + n;
        u32x4 o; o.x = pk2(s[0 * 33], s[1 * 33]); o.y = pk2(s[2 * 33], s[3 * 33]); o.z = pk2(s[4 * 33], s[5 * 33]); o.w = pk2(s[6 * 33], s[7 * 33]);
        *(u32x4*)(m.dst + (size_t)(n0 + n) * m.K + k0 + 8 * c) = o; }
    LDS_WAIT();
}
__device__ __forceinline__ void convert_weights(const Ctx& c, int l) {
    const Params& p = *c.p; (void)p;
    LAS float* scr = (LAS float*)(c.lds + c.wid * 8704);
    const int gw = c.bid * 8 + c.wid, NGW = c.G * 8;
    constexpr int CNT[8] = {2816, 1408, 2816, 1408, 1280, 512, 64, 32};
    constexpr int TOTAL = 2816 + 1408 + 2816 + 1408 + 1280 + 512 + 64 + 32;
    for (int it = gw; it < TOTAL; it += NGW) {
        int r = it, mi = 0;
#pragma unroll
        for (int i = 0; i < 7; ++i) { if (mi == i && r >= CNT[i]) { r -= CNT[i]; mi = i + 1; } }
        WMap m;
        switch (mi) {
            case 0: m = WMap{INP(p, I_F1G) + (size_t)l * DM * DFF, INP(p, I_F1U) + (size_t)l * DM * DFF, nullptr, c.W<bf16_t>(WS_WGU1), DFF, DM, 2 * DFF, 1}; break;
            case 1: m = WMap{INP(p, I_F1D) + (size_t)l * DFF * DM, nullptr, nullptr, c.W<bf16_t>(WS_WD1), DM, DFF, DM, 0}; break;
            case 2: m = WMap{INP(p, I_F2G) + (size_t)l * DM * DFF, INP(p, I_F2U) + (size_t)l * DM * DFF, nullptr, c.W<bf16_t>(WS_WGU2), DFF, DM, 2 * DFF, 1}; break;
            case 3: m = WMap{INP(p, I_F2D) + (size_t)l * DFF * DM, nullptr, nullptr, c.W<bf16_t>(WS_WD2), DM, DFF, DM, 0}; break;
            case 4: m = WMap{INP(p, I_WIN) + (size_t)l * DM * NIN, nullptr, nullptr, c.W<bf16_t>(WS_WIN), NIN, DM, 2560, 2}; break;
            case 5: m = WMap{INP(p, I_WOUT) + (size_t)l * DM * DM, nullptr, nullptr, c.W<bf16_t>(WS_WOUT), DM, DM, DM, 0}; break;
            case 6: m = WMap{INP(p, I_WUQ) + (size_t)l * 256 * 384, nullptr, INP(p, I_QNG) + l * 256, c.W<bf16_t>(WS_WUQ), 384, 256, 512, 4}; break;
            default: m = WMap{INP(p, I_WUKV) + (size_t)l * 128 * 512, nullptr, INP(p, I_KVNG) + l * 128, c.W<bf16_t>(WS_WUKV), 512, 128, 512, 5}; break;
        }
        transpose_item(m, r, scr, c.lane);
    }
}

__device__ __forceinline__ void ln_rows(const Ctx& c, const float* g, const float* bta, bf16_t* hb, int nrows) {
    const int gw = c.bid * 8 + c.wid, NGW = c.G * 8;
    f32x4 gv[4], bv[4];
#pragma unroll
    for (int j = 0; j < 4; ++j) { gv[j] = ((const f32x4*)g)[c.lane + 64 * j]; bv[j] = ((const f32x4*)bta)[c.lane + 64 * j]; }
    for (int row = gw; row < nrows; row += NGW) {
        f32x4* xr = (f32x4*)c.hrow(row) + c.lane;
        if (row + NGW < nrows) __builtin_prefetch((const void*)((const f32x4*)c.hrow(row + NGW) + c.lane), 0, 0);
        f32x4 v[4]; float s = 0.f;
#pragma unroll
        for (int j = 0; j < 4; ++j) { v[j] = xr[64 * j]; s += (v[j][0] + v[j][1]) + (v[j][2] + v[j][3]); }
        const float mean = wave_sum(s) * (1.f / DM); float s2 = 0.f;
#pragma unroll
        for (int j = 0; j < 4; ++j) { v[j] = v[j] - mean; s2 += (v[j][0] * v[j][0] + v[j][1] * v[j][1]) + (v[j][2] * v[j][2] + v[j][3] * v[j][3]); }
        const float rstd = 1.f / sqrtf(wave_sum(s2) * (1.f / DM) + EPS);
#pragma unroll
        for (int j = 0; j < 4; ++j) {
            const f32x4 o = v[j] * rstd * gv[j] + bv[j];
            xr[64 * j] = o;
            if (hb) { u32x2 w; w.x = pk2(o[0], o[1]); w.y = pk2(o[2], o[3]); *((u32x2*)(hb + (size_t)row * DM) + c.lane + 64 * j) = w; }
        }
    }
}

template <int DQK, bool BIAS>
__device__ __forceinline__ void attn_item(const Ctx& c, const bf16_t* Qb, const bf16_t* Kb, int ld, const bf16_t* Vb, int ldv, const float* bias, bf16_t* mix, int ocol, int b, int j) {
    constexpr int KP = DQK + 8, NS = DQK / 32, KCH = DQK / 8, KPT = 128 * KCH / 512;
    constexpr int VP = 136;
    constexpr int KB_BYTES = 128 * KP * 2, VB_BYTES = 64 * VP * 2;
    LAS unsigned char* lds = c.lds;
    const int tid = c.tid, lane = c.lane, w = c.wid, fr = lane & 15, fq = lane >> 4;
    const int nq = j == 0 ? 16 : 128, ntiles = j + 1;
    const int qpos0 = j == 0 ? 0 : NMETA + 128 * (j - 1);
    const bool active = (16 * w) < nq;
    bf16x8 qf[NS];
    if (active) {
        const bf16_t* qp = Qb + (size_t)row_of(b, qpos0 + 16 * w + fr) * ld + fq * 8;
#pragma unroll
        for (int s = 0; s < NS; ++s) qf[s] = *(const bf16x8*)(qp + s * 32);
    }
    u32x4 kreg[KPT], vreg[2]; float breg = 0.f;
    auto load_tile = [&](int t) {
        const int pos0 = t == 0 ? 0 : NMETA + 128 * (t - 1), nk = t == 0 ? 16 : 128;
#pragma unroll
        for (int i = 0; i < KPT; ++i) { const int q = tid + 512 * i, r = q / KCH, cc = q % KCH;
            kreg[i] = (u32x4){0u, 0u, 0u, 0u};
            if (r < nk) kreg[i] = *(const u32x4*)(Kb + (size_t)row_of(b, pos0 + r) * ld + cc * 8); }
#pragma unroll
        for (int i = 0; i < 2; ++i) { const int q = tid + 512 * i, r = q & 127, cc = q >> 7;
            vreg[i] = (u32x4){0u, 0u, 0u, 0u};
            if (r < nk) vreg[i] = *(const u32x4*)(Vb + (size_t)row_of(b, pos0 + r) * ldv + cc * 8); }
        if (BIAS && tid < 128) breg = tid < nk ? bias[pos0 + tid] : 0.f;
    };
    auto store_tile = [&](int buf) {
        LAS unsigned char* kb = lds + buf * KB_BYTES; LAS unsigned char* vb = lds + 2 * KB_BYTES + buf * VB_BYTES;
#pragma unroll
        for (int i = 0; i < KPT; ++i) { const int q = tid + 512 * i, r = q / KCH, cc = q % KCH; *(LAS u32x4*)(kb + (r * KP + cc * 8) * 2) = kreg[i]; }
#pragma unroll
        for (int i = 0; i < 2; ++i) { const int q = tid + 512 * i, r = q & 127, cc = q >> 7; LAS bf16_t* vp = (LAS bf16_t*)vb + (cc * 8) * VP + r;
            vp[0] = (bf16_t)(vreg[i].x & 0xffffu); vp[VP] = (bf16_t)(vreg[i].x >> 16); vp[2 * VP] = (bf16_t)(vreg[i].y & 0xffffu); vp[3 * VP] = (bf16_t)(vreg[i].y >> 16);
            vp[4 * VP] = (bf16_t)(vreg[i].z & 0xffffu); vp[5 * VP] = (bf16_t)(vreg[i].z >> 16); vp[6 * VP] = (bf16_t)(vreg[i].w & 0xffffu); vp[7 * VP] = (bf16_t)(vreg[i].w >> 16); }
        if (BIAS && tid < 128) ((LAS float*)(lds + 2 * KB_BYTES + 2 * VB_BYTES))[buf * 128 + tid] = breg;
    };
    float m_run = -INFINITY, l_run = 0.f;
    f32x4 o[4];
#pragma unroll
    for (int dg = 0; dg < 4; ++dg) o[dg] = zero_acc();
    const int q_local = 16 * w + fr;
    auto compute = [&](int buf, auto ngc, int mode  ) {
        constexpr int NG = decltype(ngc)::value;
        const LAS unsigned char* kb = lds + buf * KB_BYTES; const LAS unsigned char* vb = lds + 2 * KB_BYTES + buf * VB_BYTES;
        const LAS float* bb = (const LAS float*)(lds + 2 * KB_BYTES + 2 * VB_BYTES) + buf * 128;
        f32x4 sacc[NG];
#pragma unroll
        for (int g = 0; g < NG; ++g) {
            sacc[g] = BIAS ? *(const LAS f32x4*)(bb + 16 * g + 4 * fq) : zero_acc();
#pragma unroll
            for (int s = 0; s < NS; ++s) { const bf16x8 kf = *(const LAS bf16x8*)(kb + ((16 * g + fr) * KP + s * 32 + fq * 8) * 2);
                sacc[g] = __builtin_amdgcn_mfma_f32_16x16x32_bf16(kf, qf[s], sacc[g], 0, 0, 0); }
        }
        if (mode != 0) {
            const int lim = mode == 1 ? q_local : 15;
#pragma unroll
            for (int g = 0; g < NG; ++g)
#pragma unroll
                for (int e = 0; e < 4; ++e) if (16 * g + 4 * fq + e > lim) sacc[g][e] = -INFINITY;
        }
        float mx = sacc[0][0];
#pragma unroll
        for (int g = 0; g < NG; ++g)
#pragma unroll
            for (int e = 0; e < 4; ++e) mx = fmaxf(mx, sacc[g][e]);
        mx = fmaxf(mx, __shfl_xor(mx, 16)); mx = fmaxf(mx, __shfl_xor(mx, 32));
        const float m_new = fmaxf(m_run, mx);
        const float alpha = fast_exp2(m_run - m_new);
        m_run = m_new;
        float ps = 0.f;
#pragma unroll
        for (int g = 0; g < NG; ++g)
#pragma unroll
            for (int e = 0; e < 4; ++e) { const float pv = fast_exp2(sacc[g][e] - m_new); sacc[g][e] = pv; ps += pv; }
        l_run = l_run * alpha + ps;
#pragma unroll
        for (int dg = 0; dg < 4; ++dg) o[dg] = o[dg] * alpha;
#pragma unroll
        for (int sl = 0; sl < NG / 2; ++sl) {
            f32x4 pa = sacc[2 * sl], pb = sacc[2 * sl + 1];
            u32x4 pw; pw.x = pk2(pa[0], pa[1]); pw.y = pk2(pa[2], pa[3]); pw.z = pk2(pb[0], pb[1]); pw.w = pk2(pb[2], pb[3]);
            const bf16x8 pf = __builtin_bit_cast(bf16x8, pw);
#pragma unroll
            for (int dg = 0; dg < 4; ++dg) {
                const LAS unsigned char* vp = vb + ((16 * dg + fr) * VP + 32 * sl + 4 * fq) * 2;
                const u32x2 lo = *(const LAS u32x2*)vp, hi = *(const LAS u32x2*)(vp + 32);
                const u32x4 vv = {lo.x, lo.y, hi.x, hi.y};
                o[dg] = __builtin_amdgcn_mfma_f32_16x16x32_bf16(__builtin_bit_cast(bf16x8, vv), pf, o[dg], 0, 0, 0);
            }
        }
    };
    load_tile(0); store_tile(0); __syncthreads();
    for (int t = 0; t < ntiles; ++t) {
        if (t + 1 < ntiles) load_tile(t + 1);
        if (active) {
            if (t == 0) compute(0, std::integral_constant<int, 2>{}, j == 0 ? 1 : 2);
            else compute(t & 1, std::integral_constant<int, 8>{}, t == j ? 1 : 0);
        }
        if (t + 1 < ntiles) store_tile((t + 1) & 1);
        __syncthreads();
    }
#ifdef CK_TEST
    if (active && (j > 0 || b == 0)) {
        const int qpos = qpos0 + q_local; const int row = row_of(b, qpos);
        bf16_t* op = mix + (size_t)row * DM + ocol + 4 * fq;
#pragma unroll
        for (int dg = 0; dg < 4; ++dg) { float v[4];
#pragma unroll
            for (int e = 0; e < 4; ++e) { const int d = 16 * dg + 4 * fq + e; v[e] = bf2f(Vb[(size_t)row * ldv + d]); }
            u32x2 wv; wv.x = pk2(v[0], v[1]); wv.y = pk2(v[2], v[3]); *(u32x2*)(op + 16 * dg) = wv; }
    }
    if (0) {
        float l = l_run; l += __shfl_xor(l, 16); l += __shfl_xor(l, 32);
#else
    if (active && (j > 0 || b == 0)) {
        float l = l_run; l += __shfl_xor(l, 16); l += __shfl_xor(l, 32);
#endif
        const float rl = 1.f / l;
        bf16_t* op = mix + (size_t)row_of(b, qpos0 + q_local) * DM + ocol + 4 * fq;
#pragma unroll
        for (int dg = 0; dg < 4; ++dg) { u32x2 wv; wv.x = pk2(o[dg][0] * rl, o[dg][1] * rl); wv.y = pk2(o[dg][2] * rl, o[dg][3] * rl); *(u32x2*)(op + 16 * dg) = wv; }
    }
}

__device__ __forceinline__ void ssd_item_seq(const Ctx& c, int b, int h, int ph, int l) {
    const Params& p = *c.p; (void)p;
    constexpr int O_B = 0, O_C = 32768, O_X = 65536, O_Z = 73728, O_DT = 81920;
    LAS unsigned char* lds = c.lds;
    const int tid = c.tid, g = h >> 2, pl = tid >> 4, l16 = tid & 15, ns = 4 * l16;
    const bf16_t* Cn = c.W<bf16_t>(WS_CN) + g * 64; const bf16_t* Bn = c.W<bf16_t>(WS_BN) + g * 64;
    const bf16_t* XC = c.W<bf16_t>(WS_XC) + h * 64 + 32 * ph; const bf16_t* Z = c.W<bf16_t>(WS_Z) + h * 64 + 32 * ph; const float* dtv = c.W<float>(WS_DTV) + h;
    bf16_t* mix = c.W<bf16_t>(WS_HB) + h * 64 + 32 * ph + pl;
    const float Ah = -__expf(INP(p, I_ALOG)[l * 8 + h]) * LOG2E, Dh = INP(p, I_DSKIP)[l * 8 + h];
    u32x4 rB[2], rC[2], rX, rZ; float rD = 0.f;
    auto load_chunk = [&](int ch) {
        const int pos0 = ch == 0 ? 0 : NMETA + 128 * (ch - 1), nv = ch == 0 ? 16 : 128;
#pragma unroll
        for (int i = 0; i < 2; ++i) { const int q = tid + 512 * i, r = q >> 3, cc = q & 7; rB[i] = (u32x4){0u, 0u, 0u, 0u}; rC[i] = rB[i];
            if (r < nv) { const size_t ro = (size_t)row_of(b, pos0 + r) * 128 + cc * 8; rB[i] = *(const u32x4*)(Bn + ro); rC[i] = *(const u32x4*)(Cn + ro); } }
        { const int r = tid >> 2, cc = tid & 3; rX = (u32x4){0u, 0u, 0u, 0u}; rZ = rX;
            if (r < nv) { const size_t ro = (size_t)row_of(b, pos0 + r) * 512 + cc * 8; rX = *(const u32x4*)(XC + ro); rZ = *(const u32x4*)(Z + ro); } }
        if (tid < 128) rD = tid < nv ? dtv[(size_t)row_of(b, pos0 + tid) * 8] : 0.f;
    };
    auto store_chunk = [&]() {
#pragma unroll
        for (int i = 0; i < 2; ++i) { const int q = tid + 512 * i;
            LAS f32x4* db = (LAS f32x4*)(lds + O_B + q * 32); LAS f32x4* dc = (LAS f32x4*)(lds + O_C + q * 32);
            db[0] = (f32x4){bf2f(rB[i].x & 0xffffu), bf2f(rB[i].x >> 16), bf2f(rB[i].y & 0xffffu), bf2f(rB[i].y >> 16)}; db[1] = (f32x4){bf2f(rB[i].z & 0xffffu), bf2f(rB[i].z >> 16), bf2f(rB[i].w & 0xffffu), bf2f(rB[i].w >> 16)};
            dc[0] = (f32x4){bf2f(rC[i].x & 0xffffu), bf2f(rC[i].x >> 16), bf2f(rC[i].y & 0xffffu), bf2f(rC[i].y >> 16)}; dc[1] = (f32x4){bf2f(rC[i].z & 0xffffu), bf2f(rC[i].z >> 16), bf2f(rC[i].w & 0xffffu), bf2f(rC[i].w >> 16)}; }
        *(LAS u32x4*)(lds + O_X + tid * 16) = rX; *(LAS u32x4*)(lds + O_Z + tid * 16) = rZ;
        if (tid < 128) ((LAS float*)(lds + O_DT))[tid] = rD;
    };
    f32x4 S = {0.f, 0.f, 0.f, 0.f};
#define DPP_ADD(y, ctrl) y += __builtin_bit_cast(float, __builtin_amdgcn_update_dpp(0, __builtin_bit_cast(int, y), ctrl, 0xf, 0xf, true))
    load_chunk(0); store_chunk(); __syncthreads();
    for (int ch = 0; ch < 17; ++ch) {
        if (ch + 1 < 17) load_chunk(ch + 1);
        const int pos0 = ch == 0 ? 0 : NMETA + 128 * (ch - 1), nv = ch == 0 ? 16 : 128;
        const bool wr = (ch > 0 || b == 0);
        for (int i0 = 0; i0 < nv; i0 += 16) {
            float ykeep = 0.f;
#pragma unroll
            for (int k = 0; k < 16; ++k) {
                const int i = i0 + k;
                const float dt = ((const LAS float*)(lds + O_DT))[i];
                const float x = bf2f(((const LAS bf16_t*)(lds + O_X))[i * 32 + pl]);
                const f32x4 bv = *(const LAS f32x4*)(lds + O_B + (i * 64 + ns) * 4), cv = *(const LAS f32x4*)(lds + O_C + (i * 64 + ns) * 4);
                const float a = fast_exp2(dt * Ah), dx = dt * x;
                S = S * a + bv * dx;
                const f32x4 cs = cv * S;
                float y = (cs[0] + cs[1]) + (cs[2] + cs[3]);
                DPP_ADD(y, 0xB1); DPP_ADD(y, 0x4E); DPP_ADD(y, 0x141); DPP_ADD(y, 0x140);
                ykeep = (l16 == k) ? y : ykeep;
            }
            if (wr) { const int t = i0 + l16;
                const float x = bf2f(((const LAS bf16_t*)(lds + O_X))[t * 32 + pl]), zz = bf2f(((const LAS bf16_t*)(lds + O_Z))[t * 32 + pl]);
                const float o = (ykeep + Dh * x) * silu_f(zz); mix[(size_t)row_of(b, pos0 + t) * DM] = (bf16_t)(pk2(o, 0.f) & 0xffffu); }
        }
        __syncthreads();
        if (ch + 1 < 17) store_chunk();
        __syncthreads();
    }
#undef DPP_ADD
}

#define XB_TMO      128
#define XB_XCNT(j)  (256  + 64 * (j))
#define XB_XSUB(j)  (1280 + 64 * (j))
#define XB_XGEN(j)  (2304 + 64 * (j))
#define XB_TOP      3328
#define XB_TOPGEN   3392
#define XCD_BAR_WORDS 3456
#define XB_SPIN_CAP (1u << 18)

__device__ __forceinline__ unsigned xb_ld(unsigned* p)              { return __hip_atomic_load(p, __ATOMIC_RELAXED, __HIP_MEMORY_SCOPE_AGENT); }
__device__ __forceinline__ unsigned xb_add(unsigned* p, unsigned v) { return __hip_atomic_fetch_add(p, v, __ATOMIC_RELAXED, __HIP_MEMORY_SCOPE_AGENT); }
__device__ __forceinline__ unsigned xb_xcc_id() { return (unsigned)__builtin_amdgcn_s_getreg((3 << 11) | 20) & 0xFu; }
#define XB_SPIN(cond, bar) do { unsigned _sp = 0; while (cond) { __builtin_amdgcn_s_sleep(1); \
    if ((++_sp & 255u) == 0u) { if (xb_ld(&(bar)[XB_TMO])) break; if (_sp > XB_SPIN_CAP) { atomicAdd(&(bar)[XB_TMO], 1u); break; } } } } while (0)

struct XcdBarrier {
    unsigned* bar; unsigned x;
    volatile LAS unsigned* st;
};

__device__ __forceinline__ XcdBarrier xcd_barrier_post(unsigned* bar, volatile LAS unsigned* st) {
    XcdBarrier b; b.bar = bar; b.x = xb_xcc_id(); b.st = st;
    if (threadIdx.x == 0) (void)xb_add(&bar[XB_XCNT(b.x)], 1u);
    return b;
}
__device__ __forceinline__ void xcd_barrier_complete(unsigned* bar, unsigned x, unsigned& nloc, unsigned& nx) {
    const unsigned G = gridDim.x * gridDim.y * gridDim.z;
    unsigned sum, cnt, mine, sp = 0u;
    for (;;) {
        sum = 0u; cnt = 0u; mine = 0u;
#pragma unroll
        for (unsigned j = 0; j < 16; ++j) { const unsigned c = xb_ld(&bar[XB_XCNT(j)]); sum += c; cnt += (c > 0u) ? 1u : 0u; mine = (j == x) ? c : mine; }
        if (sum == G) break;
        __builtin_amdgcn_s_sleep(1);
        if ((++sp & 255u) == 0u) { if (xb_ld(&bar[XB_TMO])) break; if (sp > XB_SPIN_CAP) { atomicAdd(&bar[XB_TMO], 1u); break; } }
    }
    nloc = mine > 0u ? mine : 1u; nx = cnt > 0u ? cnt : 1u;
}

__device__ __forceinline__ void xcd_barrier(const XcdBarrier& b) {
    asm volatile("s_waitcnt vmcnt(0)" ::: "memory");
    __syncthreads();
    if (threadIdx.x == 0) {
        unsigned* bar = b.bar;
        __builtin_amdgcn_s_waitcnt(0);
        unsigned nloc = b.st[0], nx = b.st[1];
        if (nloc == 0u) { xcd_barrier_complete(bar, b.x, nloc, nx); b.st[0] = nloc; b.st[1] = nx; }
        const unsigned old = xb_add(&bar[XB_XSUB(b.x)], 1u);
        const unsigned gen = old / nloc;
        if (old + 1u == (gen + 1u) * nloc) {
            __builtin_amdgcn_fence(__ATOMIC_RELEASE, "agent");
            asm volatile("s_waitcnt vmcnt(0)" ::: "memory");
            const unsigned og = xb_add(&bar[XB_TOP], 1u);
            const unsigned tg = og / nx;
            if (og + 1u == (tg + 1u) * nx) xb_add(&bar[XB_TOPGEN], 1u);
            else XB_SPIN(xb_ld(&bar[XB_TOPGEN]) == tg, bar);
            __builtin_amdgcn_fence(__ATOMIC_ACQUIRE, "agent");
            xb_add(&bar[XB_XGEN(b.x)], 1u);
            asm volatile("s_waitcnt vmcnt(0)" ::: "memory");
        } else {
            XB_SPIN(xb_ld(&bar[XB_XGEN(b.x)]) == gen, bar);
            __builtin_amdgcn_fence(__ATOMIC_ACQUIRE, "agent");
            asm volatile("s_waitcnt vmcnt(0)" ::: "memory");
        }
    }
    __syncthreads();
}

enum { EK_SWIGLU = 0, EK_RESID = 1, EK_IN = 2, EK_UQ = 3, EK_UKV = 4 };
struct EpiAny {
    int kind; unsigned char* ws; float* hmain; float s; const float* base;
    __device__ __forceinline__ bool perm() const { return kind != EK_UQ; }
    __device__ __forceinline__ void operator()(const Acc& acc, const Unit& u, int wr, int wc, int fr, int fq) const {
        if (kind == EK_SWIGLU) { EpiSwiglu{(bf16_t*)(ws + WS_ACT)}(acc, u, wr, wc, fr, fq); }
        else if (kind == EK_RESID) { EpiResid{hmain, s, base}(acc, u, wr, wc, fr, fq); }
        else if (kind == EK_IN) { EpiIn{ws}(acc, u, wr, wc, fr, fq); }
        else if (kind == EK_UQ) { EpiUq{UqStore{(bf16_t*)(ws + WS_QM), (const float*)(ws + WS_SSQQ), (const f32x2*)(ws + WS_ROPE)}}(acc, u, wr, wc, fr, fq); }
        else { EpiUk{UkStore{(bf16_t*)(ws + WS_KM), (const float*)(ws + WS_SSQKV)}, (bf16_t*)(ws + WS_VM)}(acc, u, wr, wc, fr, fq); }
    }
};
struct GDesc { const bf16_t* A; const bf16_t* Bt; int M, N, K, kind, coff; float s; };
struct MDesc { const bf16_t* A; const bf16_t* Bt; int lda, ldb, K, n0, off2, kind; float s; };
enum { MK_SWIGLU = 0, MK_RESID = 1, MK_IN = 2, MK_UQ = 3, MK_UKV = 4 };

template <int MASK>
__global__ void __launch_bounds__(512, 2) mk_fwd(Params prm) {
    extern __shared__ __attribute__((aligned(16))) unsigned char lds_raw[];
    const Params& p = prm;
#if MK_LAUNCHES == 1
    volatile LAS unsigned* xb_st = (volatile LAS unsigned*)((LAS unsigned char*)lds_raw + 133632);
    if (threadIdx.x < 2) xb_st[threadIdx.x] = 0u;
    __syncthreads();
    const XcdBarrier xbar = xcd_barrier_post((unsigned*)(prm.ws + WS_BAR), xb_st);
#endif
#ifdef NO_LOOP
    { int ph = p.ph_lo;
#else
    for (int ph = p.ph_lo; ph < p.ph_hi; ++ph) {
#endif
        Ctx c;
#define FRESH() do { unsigned char* ws_ = prm.ws; float* out_ = prm.out; int tid_ = threadIdx.x; unsigned ldsb = 0u; \
          asm volatile("" : "+s"(ws_), "+s"(out_), "+v"(tid_), "+s"(ldsb)); \
          c.lds = (LAS unsigned char*)lds_raw + ldsb; \
          c.tid = tid_; c.lane = tid_ & 63; c.wid = __builtin_amdgcn_readfirstlane(tid_ >> 6); c.bid = blockIdx.x; c.G = gridDim.x; \
          c.p = &prm; c.ws = ws_; c.hmain = out_; c.hmeta = (float*)(ws_ + WS_HMETA); } while (0)
        FRESH();
        const int l = ph == 0 ? 0 : (ph - 1) / 12, k = ph == 0 ? -1 : (ph - 1) % 12;
        const bool lastffn = (l == 1 && k >= 9);
#ifdef DUP_K
        const int nrep = (k == DUP_K) ? 2 : 1;
#else
        const int nrep = 1;
#endif
        for (int rep = 0; rep < nrep; ++rep) {
        if (rep > 0) { cg::this_grid().sync(); if (blockIdx.x == 0 && threadIdx.x == 0) ((unsigned*)(prm.ws + WS_CTL))[0] = 0u; cg::this_grid().sync(); FRESH(); }

        if (EN(1)) {
#ifdef SSD_T6
            const int ng = (k == 0 || k == 9 || k == 1 || k == 10 || k == 7 || k == 3) ? 1 : 0;
#else
            const int ng = (k == 0 || k == 9 || k == 1 || k == 10 || k == 7 || k == 3) ? 1 : (k == 4 ? 2 : 0);
#endif
            for (int gi = 0; gi < ng; ++gi) {
                FRESH();
                GDesc d;
                bf16_t* HB = c.W<bf16_t>(WS_HB); bf16_t* ACT = c.W<bf16_t>(WS_ACT);
                if (k == 0 || k == 9) d = GDesc{HB, c.W<bf16_t>(k == 0 ? WS_WGU1 : WS_WGU2), RMAIN, 2 * DFF, DM, EK_SWIGLU, 0, 0.f};
                else if (k == 1 || k == 10) d = GDesc{ACT, c.W<bf16_t>(k == 1 ? WS_WD1 : WS_WD2), RMAIN, DM, DFF, EK_RESID, 0, 0.5f};
                else if (k == 7) d = GDesc{HB, c.W<bf16_t>(WS_WOUT), RMAIN, DM, DM, EK_RESID, 0, 1.f};
                else if (k == 3) d = GDesc{HB, c.W<bf16_t>(WS_WIN), RMAIN, 2560, DM, EK_IN, 0, 0.f};
                else if (gi == 0) d = GDesc{c.W<bf16_t>(WS_CQ), c.W<bf16_t>(WS_WUQ), RMAIN, 512, 256, EK_UQ, 0, 0.f};
                else d = GDesc{c.W<bf16_t>(WS_CKV), c.W<bf16_t>(WS_WUKV), RMAIN, 512, 128, EK_UKV, 128, 0.f};
                pg8::Gemm g{d.A, d.Bt, d.M, d.N, d.K}; pg8::StaticOrder S; S.init(d.M, d.N, c.G, (c.bid + c.G - d.coff) % c.G);
                const bool firstffn = (l == 0 && k == 1);
                EpiAny E{d.kind, c.ws, c.hmain, d.s, firstffn ? INP(p, I_X) : (const float*)c.hmain};
                pg8::gemm_phase<EpiAny, pg8::StaticOrder, true>(c.lds, g, S, E);
            }
        }
        if (EN(2)) {
            FRESH();
            const int nmu = lastffn ? 0 : (k == 0 || k == 9) ? DFF / 16 : (k == 1 || k == 10 || k == 7) ? DM / 32 : k == 3 ? 80 : k == 4 ? 12 + 16 : 0;
            for (int mu = (2 * c.bid >= c.G) ? c.G - 1 - c.bid : nmu; mu < nmu; mu += c.G / 2) {
                FRESH();
                bf16_t* HB = c.W<bf16_t>(WS_HB); bf16_t* ACT = c.W<bf16_t>(WS_ACT);
                MDesc m;
                if (k == 0 || k == 9) { const int a0 = 16 * mu; m = MDesc{HB + (size_t)RMAIN * DM, c.W<bf16_t>(k == 0 ? WS_WGU1 : WS_WGU2), DM, DM, DM, 256 * (a0 >> 7) + (a0 & 127), 128, MK_SWIGLU, 0.f}; }
                else if (k == 1 || k == 10) m = MDesc{ACT + (size_t)RMAIN * DFF, c.W<bf16_t>(k == 1 ? WS_WD1 : WS_WD2), DFF, DFF, DFF, 32 * mu, 16, MK_RESID, 0.5f};
                else if (k == 7) m = MDesc{HB + (size_t)RMAIN * DM, c.W<bf16_t>(WS_WOUT), DM, DM, DM, 32 * mu, 16, MK_RESID, 1.f};
                else if (k == 3) m = MDesc{HB + (size_t)RMAIN * DM, c.W<bf16_t>(WS_WIN), DM, DM, DM, 32 * mu, 16, MK_IN, 0.f};
                else if (mu < 12) m = MDesc{c.W<bf16_t>(WS_CQ) + (size_t)RMAIN * 256, c.W<bf16_t>(WS_WUQ), 256, 256, 256, 32 * mu, 16, MK_UQ, 0.f};
                else m = MDesc{c.W<bf16_t>(WS_CKV) + (size_t)RMAIN * 128, c.W<bf16_t>(WS_WUKV), 128, 128, 128, 32 * (mu - 12), 16, MK_UKV, 0.f};
                unsigned char* ws = c.ws; float* hm = c.hmeta; const int lane = c.lane;
                meta_unit(c, m.A, m.lda, m.Bt, m.ldb, m.K, m.n0, m.off2, [&](int r, int ca, f32x4 va, int cb, f32x4 vb) {
                    if (m.kind == MK_SWIGLU) {
                        const int a0 = 128 * (m.n0 >> 8) + (m.n0 & 127);
                        u32x2 w; w.x = pk2(silu_f(va[0]) * vb[0], silu_f(va[1]) * vb[1]); w.y = pk2(silu_f(va[2]) * vb[2], silu_f(va[3]) * vb[3]);
                        *(u32x2*)((bf16_t*)(ws + WS_ACT) + (size_t)(RMAIN + r) * DFF + a0 + (ca - m.n0)) = w;
                    } else if (m.kind == MK_RESID) {
                        const float* bm = (l == 0 && k == 1) ? INP(p, I_META) : (const float*)hm;
                        *(f32x4*)(hm + (size_t)r * DM + ca) = *(const f32x4*)(bm + (size_t)r * DM + ca) * ALPHA + va * m.s;
                        *(f32x4*)(hm + (size_t)r * DM + cb) = *(const f32x4*)(bm + (size_t)r * DM + cb) * ALPHA + vb * m.s;
                    } else if (m.kind == MK_IN) {
                        InStore st{(bf16_t*)(ws + WS_Z), (bf16_t*)(ws + WS_XBC), (bf16_t*)(ws + WS_FQ), (bf16_t*)(ws + WS_FK), (bf16_t*)(ws + WS_CQ), (bf16_t*)(ws + WS_CKV), (float*)(ws + WS_SMALL), (bf16_t*)(ws + WS_FV)};
                        st.store4(RMAIN + r, ca, va); st.store4(RMAIN + r, cb, vb);
                        if (ca >= 1792 && ca < 2176) {
                            float sq = va[0] * va[0] + va[1] * va[1] + va[2] * va[2] + va[3] * va[3] + vb[0] * vb[0] + vb[1] * vb[1] + vb[2] * vb[2] + vb[3] * vb[3];
                            sq += __shfl_xor(sq, 16); sq += __shfl_xor(sq, 32);
                            if ((lane >> 4) == 0) atomicAdd((float*)(ws + (ca < 2048 ? WS_SSQQ : WS_SSQKV)) + (size_t)(RMAIN + r) * 4, sq);
                        }
                    } else if (m.kind == MK_UQ) {
                        UqStore{(bf16_t*)(ws + WS_QM), (const float*)(ws + WS_SSQQ), (const f32x2*)(ws + WS_ROPE)}.store(RMAIN + r, m.n0, ca - m.n0, va, vb);
                    } else {
                        if (ca < 256) { UkStore uks{(bf16_t*)(ws + WS_KM), (const float*)(ws + WS_SSQKV)}; uks.store4(RMAIN + r, ca, va); uks.store4(RMAIN + r, cb, vb); }
                        else { const float sc = __builtin_amdgcn_rsqf(ssq4((const float*)(ws + WS_SSQKV), RMAIN + r) * (1.f / 128.f) + EPS); bf16_t* vm = (bf16_t*)(ws + WS_VM) + (size_t)(RMAIN + r) * 256;
                            u32x2 w; w.x = pk2(va[0] * sc, va[1] * sc); w.y = pk2(va[2] * sc, va[3] * sc); *(u32x2*)(vm + (ca - 256)) = w;
                            w.x = pk2(vb[0] * sc, vb[1] * sc); w.y = pk2(vb[2] * sc, vb[3] * sc); *(u32x2*)(vm + (cb - 256)) = w; }
                    }
                });
            }
        }
        FRESH();
        const int gtid = c.bid * 512 + c.tid, GT = c.G * 512;
        bf16_t* HB = c.W<bf16_t>(WS_HB);
        unsigned* ctl = c.W<unsigned>(WS_CTL);
        LAS int* s_item = (LAS int*)(c.lds + 133120);
        if (EN(0) && ph == 0) {
            convert_weights(c, 0);
            f32x2* rope = c.W<f32x2>(WS_ROPE);
            for (int i = gtid; i < LTOT * 16; i += GT) {
                const int pos = i >> 4, fi = i & 15;
                const float inv = exp2f(-(float)fi * (13.287712379549449f / 16.f));
                const float ang = (float)pos * inv;
                float t = ang * 0.15915494309189535f; t = t - rintf(t);
                rope[i] = (f32x2){__builtin_amdgcn_cosf(t), __builtin_amdgcn_sinf(t)};
            }
            for (int i = gtid; i < RT * 256; i += GT) {
                const int row = i >> 8, c4 = i & 255;
                const f32x4 v = row < RMAIN ? ((const f32x4*)INP(p, I_X))[(size_t)row * 256 + c4] : ((const f32x4*)INP(p, I_META))[(size_t)(row - RMAIN) * 256 + c4];
                u32x2 w; w.x = pk2(v[0], v[1]); w.y = pk2(v[2], v[3]); ((u32x2*)(HB + (size_t)row * DM))[c4] = w;
            }
        } else if (EN(3) && (k == 2 || k == 8 || k == 11)) {
            const int gi = k == 2 ? I_LN1G : k == 8 ? I_LN2G : I_LN3G;
            const bool last = (l == 1 && k == 11);
            ln_rows(c, INP(p, gi) + l * DM, INP(p, gi + 1) + l * DM, last ? nullptr : HB, last ? RMAIN : RT);
            if (k == 2) {
                float* z1 = c.W<float>(WS_SSQQ); float* z2 = c.W<float>(WS_SSQKV); float* z3 = c.W<float>(WS_SSQS);
                for (int i = gtid; i < NMETA * 4; i += GT) { z1[(size_t)RMAIN * 4 + i] = 0.f; z2[(size_t)RMAIN * 4 + i] = 0.f; } (void)z3;
                if (gtid == 0) ctl[0] = 0u;
            }
            if (k == 11 && l == 0) convert_weights(c, 1);
        } else if (EN(8) && k == 4) {
            bf16_t* Km = c.W<bf16_t>(WS_KM);
#ifndef SKIP_P5
            {
                const bf16_t* XBC = c.W<bf16_t>(WS_XBC); bf16_t* XC = c.W<bf16_t>(WS_XC); bf16_t* BN = c.W<bf16_t>(WS_BN); bf16_t* CN = c.W<bf16_t>(WS_CN);
                bf16_t* XT = c.W<bf16_t>(WS_XT); bf16_t* BT = c.W<bf16_t>(WS_BT);
                const float* cw = INP(p, I_CONVW) + (size_t)l * 4 * 768; const float* cbias = INP(p, I_CONVB) + (size_t)l * 768;
                for (int un0 = c.bid; un0 < NB * 258; un0 += 2 * c.G) {
                    const int un1 = un0 + c.G; const bool has1 = un1 < NB * 258;
                    const int b0 = un0 / 258, p00 = (un0 % 258) * 8, b1 = has1 ? un1 / 258 : b0, p01 = has1 ? (un1 % 258) * 8 : p00;
                    for (int ch = c.tid; ch < 768; ch += 512) {
                        const float w0 = cw[ch], w1 = cw[768 + ch], w2 = cw[1536 + ch], w3 = cw[2304 + ch], bs = cbias[ch];
                        bf16_t xa[11], xb[11];
#pragma unroll
                        for (int i = 0; i < 11; ++i) { const int pa = p00 - 3 + i, pb = p01 - 3 + i;
                            xa[i] = XBC[(size_t)row_of(b0, pa < 0 ? 0 : pa) * 768 + ch]; xb[i] = XBC[(size_t)row_of(b1, pb < 0 ? 0 : pb) * 768 + ch]; }
#pragma unroll
                        for (int u = 0; u < 2; ++u) {
                            if (u == 1 && !has1) break;
                            const int b = u ? b1 : b0, p0 = u ? p01 : p00;
                            float xin[11];
#pragma unroll
                            for (int i = 0; i < 11; ++i) xin[i] = (p0 - 3 + i) >= 0 ? bf2f(u ? xb[i] : xa[i]) : 0.f;
                            float o[8];
#pragma unroll
                            for (int i = 0; i < 8; ++i) o[i] = silu_f(bs + w0 * xin[i] + w1 * xin[i + 1] + w2 * xin[i + 2] + w3 * xin[i + 3]);
                            u32x4 pw; pw.x = pk2(o[0], o[1]); pw.y = pk2(o[2], o[3]); pw.z = pk2(o[4], o[5]); pw.w = pk2(o[6], o[7]);
                            if (ch < 512) *(u32x4*)(XT + ((size_t)b * 512 + ch) * LP + p0) = pw;
                            else if (ch < 640) *(u32x4*)(BT + ((size_t)b * 128 + ch - 512) * LP + p0) = pw;
                        }
                    }
                }
            }
#endif
#ifndef SKIP_P6
            {
                const bf16_t* XBC = c.W<bf16_t>(WS_XBC); bf16_t* XC = c.W<bf16_t>(WS_XC); bf16_t* BN = c.W<bf16_t>(WS_BN); bf16_t* CN = c.W<bf16_t>(WS_CN);
                const float* cw = INP(p, I_CONVW) + (size_t)l * 4 * 768; const float* cbias = INP(p, I_CONVB) + (size_t)l * 768;
                auto nat_finish = [&](int row, int cg8, int pos, const u32x4 (&xv4)[4]) {
                    float acc8[8];
                    { const f32x4 b0 = *(const f32x4*)(cbias + cg8), b1 = *(const f32x4*)(cbias + cg8 + 4);
                      acc8[0] = b0[0]; acc8[1] = b0[1]; acc8[2] = b0[2]; acc8[3] = b0[3]; acc8[4] = b1[0]; acc8[5] = b1[1]; acc8[6] = b1[2]; acc8[7] = b1[3]; }
#pragma unroll
                    for (int kk = 0; kk < 4; ++kk) {
                        if (pos - 3 + kk >= 0) {
                            const u32x4 xv = xv4[kk];
                            const f32x4 w0 = *(const f32x4*)(cw + kk * 768 + cg8), w1 = *(const f32x4*)(cw + kk * 768 + cg8 + 4);
                            acc8[0] += w0[0] * bf2f(xv.x & 0xffffu); acc8[1] += w0[1] * bf2f(xv.x >> 16); acc8[2] += w0[2] * bf2f(xv.y & 0xffffu); acc8[3] += w0[3] * bf2f(xv.y >> 16);
                            acc8[4] += w1[0] * bf2f(xv.z & 0xffffu); acc8[5] += w1[1] * bf2f(xv.z >> 16); acc8[6] += w1[2] * bf2f(xv.w & 0xffffu); acc8[7] += w1[3] * bf2f(xv.w >> 16);
                        }
                    }
                    u32x4 o; o.x = pk2(silu_f(acc8[0]), silu_f(acc8[1])); o.y = pk2(silu_f(acc8[2]), silu_f(acc8[3])); o.z = pk2(silu_f(acc8[4]), silu_f(acc8[5])); o.w = pk2(silu_f(acc8[6]), silu_f(acc8[7]));
                    if (cg8 < 512) *(u32x4*)(XC + (size_t)row * 512 + cg8) = o; else if (cg8 < 640) *(u32x4*)(BN + (size_t)row * 128 + cg8 - 512) = o; else *(u32x4*)(CN + (size_t)row * 128 + cg8 - 640) = o;
                };
                for (int ia = gtid; ia < RT * 96; ia += 2 * GT) {
                    const int ib0 = ia + GT; const bool hb = ib0 < RT * 96; const int ib = hb ? ib0 : ia;
                    const int rowa = ia / 96, cga = (ia % 96) * 8, posa = pos_of_row(rowa), ba = rowa < RMAIN ? rowa >> 11 : 0;
                    const int rowb = ib / 96, cgb = (ib % 96) * 8, posb = pos_of_row(rowb), bb = rowb < RMAIN ? rowb >> 11 : 0;
                    u32x4 xa[4], xb[4];
#pragma unroll
                    for (int kk = 0; kk < 4; ++kk) { const int pa = posa - 3 + kk, pb = posb - 3 + kk;
                        xa[kk] = *(const u32x4*)(XBC + (size_t)row_of(ba, pa < 0 ? 0 : pa) * 768 + cga); xb[kk] = *(const u32x4*)(XBC + (size_t)row_of(bb, pb < 0 ? 0 : pb) * 768 + cgb); }
                    nat_finish(rowa, cga, posa, xa);
                    if (hb) nat_finish(rowb, cgb, posb, xb);
                }
            }
            {
                const float* SM = c.W<float>(WS_SMALL); float* dtv = c.W<float>(WS_DTV); const float* dtb = INP(p, I_DTB) + l * 8;
                for (int i = gtid; i < RT * 8; i += GT) { const int row = i >> 3, hh = i & 7; const float x = SM[(size_t)row * 64 + 32 + hh] + dtb[hh];
                    dtv[i] = fmaxf(x, 0.f) + log1pf(__expf(-fabsf(x))); }
                const f32x2* rp = c.W<f32x2>(WS_ROPE);
                for (int i = gtid; i < RT * 16; i += GT) { const int row = i >> 4, fi = i & 15; const f32x2 cs = rp[(size_t)pos_of_row(row) * 16 + fi];
                    const float x1 = SM[(size_t)row * 64 + fi], x2 = SM[(size_t)row * 64 + 16 + fi];
                    const bf16_t o1 = (bf16_t)(pk2(x1 * cs.x - x2 * cs.y, 0.f) & 0xffffu), o2 = (bf16_t)(pk2(x2 * cs.x + x1 * cs.y, 0.f) & 0xffffu);
#pragma unroll
                    for (int hh = 0; hh < 4; ++hh) { Km[(size_t)row * 384 + hh * 96 + 64 + fi] = o1; Km[(size_t)row * 384 + hh * 96 + 80 + fi] = o2; } }
                float* cbv = c.W<float>(WS_CB); const float* ffb = INP(p, I_FFB) + l * 4;
                const int gw = c.bid * 8 + c.wid;
                if (gw < 32) {
                    const int b = gw >> 2, hh = gw & 3; const float fb = ffb[hh];
                    float v[33]; float s = 0.f;
#pragma unroll
                    for (int i = 0; i < 33; ++i) { const int pos = c.lane * 33 + i; float lf = 0.f;
                        if (pos < LTOT) { const float x = SM[(size_t)row_of(b, pos) * 64 + 40 + hh] + fb; lf = fminf(x, 0.f) - log1pf(__expf(-fabsf(x))); }
                        s += lf; v[i] = s; }
                    float t = s;
#pragma unroll
                    for (int o = 1; o < 64; o <<= 1) { const float u = __shfl_up(t, o); if (c.lane >= o) t += u; }
                    const float base = t - s;
#pragma unroll
                    for (int i = 0; i < 33; ++i) { const int pos = c.lane * 33 + i; if (pos < LTOT) cbv[(size_t)(b * 4 + hh) * LP + pos] = -(base + v[i]) * LOG2E; }
                }
            }
#endif
        } else if (EN(6) && k == 5) {
            bf16_t* MIX = HB;
            const bf16_t* FQ = c.W<bf16_t>(WS_FQ); const bf16_t* FK = c.W<bf16_t>(WS_FK); const bf16_t* FV = c.W<bf16_t>(WS_FV); const float* cbv = c.W<float>(WS_CB);
            const bf16_t* Qm = c.W<bf16_t>(WS_QM); const bf16_t* Km = c.W<bf16_t>(WS_KM); const bf16_t* Vm = c.W<bf16_t>(WS_VM);
            int qn = 0; (void)qn;
            for (;;) {
                __syncthreads();
#ifdef STATIC_Q
                if (c.tid == 0) { *s_item = c.bid + qn * c.G; } ++qn;
#else
                if (c.tid == 0) *s_item = (int)atomicAdd(ctl, 1u);
#endif
                __syncthreads();
                int it = *s_item; asm volatile("" : "+v"(it)); it = __builtin_amdgcn_readfirstlane(it);
                if (it >= 128 + 1024 + 8) break;
                FRESH();
#ifndef SKIP_SSD
#ifdef DUP_K
                if (it < 128 && rep > 0) continue;
#endif
                if (it < 128) { ssd_item_seq(c, it >> 4, (it >> 1) & 7, it & 1, l); continue; }
#endif
                int j, mixer, bh;
                if (it < 128 + 1024) { const int r = it - 128; j = 16 - (r >> 6); mixer = (r >> 5) & 1; bh = r & 31; }
                else { const int r = it - 128 - 1024; j = 0; mixer = r >> 2; bh = r & 3; }
                const int b = bh >> 2, hh = bh & 3;
#ifndef SKIP_FOX
                if (mixer == 0) attn_item<64, true>(c, FQ + hh * 64, FK + hh * 64, 256, FV + hh * 64, 256, cbv + (size_t)(b * 4 + hh) * LP, MIX, 512 + hh * 64, b, j);
#endif
#ifndef SKIP_MLA
                if (mixer == 1) attn_item<96, false>(c, Qm + hh * 96, Km + hh * 96, 384, Vm + hh * 64, 256, nullptr, MIX, 768 + hh * 64, b, j);
#endif
            }
        } else if (EN(7) && k == 6) {
            bf16_t* MIX = HB; const float* ng = INP(p, I_SNG) + l * 512;
            for (int i = gtid; i < RT * 64; i += GT) {
                const int row = i >> 6, c8 = (i & 63) * 8;
                u32x4* q = (u32x4*)(MIX + (size_t)row * DM + c8); const u32x4 v = *q;
                const float t0 = bf2f(v.x & 0xffffu), t1 = bf2f(v.x >> 16), t2 = bf2f(v.y & 0xffffu), t3 = bf2f(v.y >> 16), t4 = bf2f(v.z & 0xffffu), t5 = bf2f(v.z >> 16), t6 = bf2f(v.w & 0xffffu), t7 = bf2f(v.w >> 16);
                float ss = ((t0 * t0 + t1 * t1) + (t2 * t2 + t3 * t3)) + ((t4 * t4 + t5 * t5) + (t6 * t6 + t7 * t7));
                ss += __shfl_xor(ss, 1); ss += __shfl_xor(ss, 2); ss += __shfl_xor(ss, 4); ss += __shfl_xor(ss, 8); ss += __shfl_xor(ss, 16);
                const float rs = __builtin_amdgcn_rsqf(ss * (1.f / 256.f) + EPS);
                const f32x4 g0 = *(const f32x4*)(ng + c8), g1 = *(const f32x4*)(ng + c8 + 4);
                u32x4 o;
                o.x = pk2(t0 * rs * g0[0], t1 * rs * g0[1]); o.y = pk2(t2 * rs * g0[2], t3 * rs * g0[3]); o.z = pk2(t4 * rs * g1[0], t5 * rs * g1[1]); o.w = pk2(t6 * rs * g1[2], t7 * rs * g1[3]);
                *q = o;
            }
        }
        }
#if MK_LAUNCHES == 1
        if (ph + 1 < p.ph_hi) {
            if (ph == 0) cg::this_grid().sync();
            else xcd_barrier(xbar);
        }
#endif
    }
}

extern "C" void kernel_launch(void* const* d_in, const int* in_sizes, int n_in, void* d_out, int out_size, void* d_ws, size_t ws_size, hipStream_t stream) {
    static int grid = 0;
    if (grid == 0) {
        if (n_in != 27 || ws_size < WS_END) { fprintf(stderr, "kernel_launch: unexpected inputs (n_in %d, ws %zu, need %zu)\n", n_in, ws_size, (size_t)WS_END); grid = -1; return; }
        int dev = 0, cus = 0, per_cu = 0;
        (void)hipGetDevice(&dev); (void)hipDeviceGetAttribute(&cus, hipDeviceAttributeMultiprocessorCount, dev);
        const void* fn = (const void*)mk_fwd<PH_MASK>;
        if (hipFuncSetAttribute(fn, hipFuncAttributeMaxDynamicSharedMemorySize, LDS_BYTES) != hipSuccess) { fprintf(stderr, "kernel_launch: hipFuncSetAttribute failed\n"); grid = -1; return; }
        if (hipOccupancyMaxActiveBlocksPerMultiprocessor(&per_cu, fn, 512, LDS_BYTES) != hipSuccess || per_cu < 1) { fprintf(stderr, "kernel_launch: occupancy query failed (%d)\n", per_cu); (void)hipGetLastError(); per_cu = 1; }
        grid = cus * per_cu;
    }
    if (grid < 0) return;
    if (hipMemsetAsync((char*)d_ws + WS_BAR, 0, 16384, stream) != hipSuccess) { fprintf(stderr, "kernel_launch: hipMemsetAsync failed\n"); return; }
    Params prm{};
    for (int i = 0; i < 27; ++i) prm.in[i] = (const float*)d_in[i];
    prm.out = (float*)d_out; prm.ws = (unsigned char*)d_ws;
#ifndef NPH_LIMIT
#define NPH_LIMIT 25
#endif
    constexpr int NPH = NPH_LIMIT;
#if MK_LAUNCHES == 1
    prm.ph_lo = 0; prm.ph_hi = NPH;
    void* args[] = {&prm};
    hipError_t e = hipLaunchCooperativeKernel((const void*)mk_fwd<PH_MASK>, dim3(grid), dim3(512), args, LDS_BYTES, stream);
    if (e != hipSuccess) fprintf(stderr, "cooperative launch failed: %s (grid %d)\n", hipGetErrorString(e), grid);
#else
    for (int ph = 0; ph < NPH; ++ph) { prm.ph_lo = ph; prm.ph_hi = ph + 1; hipLaunchKernelGGL(mk_fwd<PH_MASK>, dim3(grid), dim3(512), LDS_BYTES, stream, prm); }
#endif
}
```

```cpp
#include <hip/hip_runtime.h>
#include <hip/hip_cooperative_groups.h>
#include <cstdio>
#include <cstdint>
#include <type_traits>
namespace cg = cooperative_groups;

#ifndef PH_MASK
#define PH_MASK 0x1ff
#endif
#define EN(n) ((MASK >> (n)) & 1)


#ifndef MK_LAUNCHES
#define MK_LAUNCHES 1
#endif
#if MK_LAUNCHES != 1
#define NO_LOOP 1
#endif

#define LAS __attribute__((address_space(3)))
typedef unsigned short bf16_t;
typedef short bf16x8 __attribute__((ext_vector_type(8)));
typedef short s16x4 __attribute__((ext_vector_type(4)));
typedef float f32x4 __attribute__((ext_vector_type(4)));
typedef float f32x2 __attribute__((ext_vector_type(2)));
typedef unsigned u32x4 __attribute__((ext_vector_type(4)));
typedef unsigned u32x2 __attribute__((ext_vector_type(2)));

constexpr int NB = 8, SEQ = 2048, NMETA = 16, LTOT = 2064, DM = 1024, DFF = 2816;
constexpr int RMAIN = NB * SEQ;
constexpr int RT = RMAIN + NMETA;
constexpr int LP = 2080;
constexpr int NIN = 2476;
constexpr float ALPHA = 1.4142135623730951f;
constexpr float EPS = 1e-5f;
constexpr float LOG2E = 1.4426950408889634f;
constexpr float FOX_QS = 0.125f * LOG2E;
constexpr float MLA_QS = 0.10206207261596575f * LOG2E;

constexpr size_t al256(size_t x) { return (x + 255) & ~(size_t)255; }
constexpr size_t WS_CTL = 0;
constexpr size_t WS_BAR = 4096;
constexpr size_t WS_HMETA = 4096 + 16384;
constexpr size_t WS_ROPE = al256(WS_HMETA + (size_t)NMETA * DM * 4);
constexpr size_t WS_SSQQ = al256(WS_ROPE + (size_t)LTOT * 16 * 8);
constexpr size_t WS_SSQKV = al256(WS_SSQQ + (size_t)RT * 16);
constexpr size_t WS_SSQS = al256(WS_SSQKV + (size_t)RT * 16);
constexpr size_t WS_DTV = al256(WS_SSQS + (size_t)RT * 8 * 4);
constexpr size_t WS_CB = al256(WS_DTV + (size_t)RT * 8 * 4);
constexpr size_t WS_SMALL = al256(WS_CB + (size_t)NB * 4 * LP * 4);
constexpr size_t WS_WGU1 = al256(WS_SMALL + (size_t)RT * 64 * 4);
constexpr size_t WS_WD1 = al256(WS_WGU1 + (size_t)2 * DFF * DM * 2);
constexpr size_t WS_WGU2 = al256(WS_WD1 + (size_t)DM * DFF * 2);
constexpr size_t WS_WD2 = al256(WS_WGU2 + (size_t)2 * DFF * DM * 2);
constexpr size_t WS_WIN = al256(WS_WD2 + (size_t)DM * DFF * 2);
constexpr size_t WS_WOUT = al256(WS_WIN + (size_t)2560 * DM * 2);
constexpr size_t WS_WUQ = al256(WS_WOUT + (size_t)DM * DM * 2);
constexpr size_t WS_WUKV = al256(WS_WUQ + (size_t)512 * 256 * 2);
constexpr size_t WS_HB = al256(WS_WUKV + (size_t)512 * 128 * 2);
constexpr size_t WS_ACT = al256(WS_HB + (size_t)RT * DM * 2);
constexpr size_t WS_Z = WS_ACT;
constexpr size_t WS_XBC = al256(WS_Z + (size_t)RT * 512 * 2);
constexpr size_t WS_FQ = al256(WS_XBC + (size_t)RT * 768 * 2);
constexpr size_t WS_FK = al256(WS_FQ + (size_t)RT * 256 * 2);
constexpr size_t WS_CQ = al256(WS_FK + (size_t)RT * 256 * 2);
constexpr size_t WS_CKV = al256(WS_CQ + (size_t)RT * 256 * 2);
constexpr size_t WS_ACT_END = al256(WS_ACT + (size_t)RT * DFF * 2);
constexpr size_t WS_FV = al256(WS_CKV + (size_t)RT * 128 * 2);
static_assert(WS_FV + (size_t)RT * 256 * 2 <= WS_ACT_END, "mixer buffers overflow the act alias");
constexpr size_t WS_XC = WS_ACT_END;
constexpr size_t WS_BN = al256(WS_XC + (size_t)RT * 512 * 2);
constexpr size_t WS_CN = al256(WS_BN + (size_t)RT * 128 * 2);
constexpr size_t WS_XT = al256(WS_CN + (size_t)RT * 128 * 2);
constexpr size_t WS_BT = al256(WS_XT + (size_t)NB * 512 * LP * 2);
constexpr size_t WS_QM = al256(WS_BT + (size_t)NB * 128 * LP * 2);
constexpr size_t WS_KM = al256(WS_QM + (size_t)RT * 384 * 2);
constexpr size_t WS_VM = al256(WS_KM + (size_t)RT * 384 * 2);
constexpr size_t WS_END = al256(WS_VM + (size_t)RT * 256 * 2);
static_assert(WS_END <= (size_t)268435456, "workspace map exceeds 256 MiB");

constexpr int LDS_BYTES = 135168;

__device__ __forceinline__ float bf2f(unsigned v) { return __uint_as_float(v << 16); }
__device__ __forceinline__ unsigned pk2(float lo, float hi) { unsigned r; asm("v_cvt_pk_bf16_f32 %0, %1, %2" : "=v"(r) : "v"(lo), "v"(hi)); return r; }
__device__ __forceinline__ float fast_exp2(float x) { return __builtin_amdgcn_exp2f(x); }
__device__ __forceinline__ float silu_f(float x) { return x * __builtin_amdgcn_rcpf(1.f + fast_exp2(-x * LOG2E)); }
__device__ __forceinline__ int row_of(int b, int pos) { return pos < NMETA ? RMAIN + pos : b * SEQ + pos - NMETA; }
__device__ __forceinline__ int pos_of_row(int row) { return row < RMAIN ? NMETA + (row & (SEQ - 1)) : row - RMAIN; }
#define LDS_WAIT() asm volatile("s_waitcnt lgkmcnt(0)" ::: "memory")
__device__ __forceinline__ float ssq4(const float* p, int row) { const f32x4 q = *(const f32x4*)(p + (size_t)row * 4); return (q[0] + q[1]) + (q[2] + q[3]); }
__device__ __forceinline__ f32x4 zero_acc() { f32x4 z = {0.f, 0.f, 0.f, 0.f}; asm volatile("" : "+v"(z)); return z; }
__device__ __forceinline__ float wave_sum(float v) {
#define WS_DPP(ctrl) v += __builtin_bit_cast(float, __builtin_amdgcn_update_dpp(0, __builtin_bit_cast(int, v), ctrl, 0xf, 0xf, true))
    WS_DPP(0xB1); WS_DPP(0x4E); WS_DPP(0x141); WS_DPP(0x140);
#undef WS_DPP
    v += __shfl_xor(v, 16); v += __shfl_xor(v, 32);
    return v;
}

namespace pg8 {
constexpr int BM = 256, BK = 64, HALF = 128, HTB = HALF * BK * 2, STAGE_BYTES = 8 * HTB, NXCD = 8, WGM = 8;
__host__ __device__ __forceinline__ int lds_byte(int r, int c) { const int st = (r >> 4) * 2 + (c >> 5), rr = r & 15, cc = c & 31, ob = rr * 64 + cc * 2; return st * 1024 + (ob ^ (((ob >> 9) & 1) << 5)); }
__host__ __device__ __forceinline__ void stage_rc(int b, int& R, int& C) { const int st = b / 1024, sb = b % 1024, swz = sb ^ (((sb >> 9) & 1) << 5); R = (st >> 1) * 16 + swz / 64; C = (st & 1) * 32 + (swz % 64) / 2; }
__host__ __device__ __forceinline__ int perm32(int rho) { const int n = rho >> 4, i = rho & 15; return 8 * (i >> 2) + 4 * n + (i & 3); }
struct Unit { int pm, pn; };
struct Gemm { const bf16_t* A; const bf16_t* Bt; int M, N, K; };
struct StaticOrder {
    int nM, nN, nwg, G, c;
    __device__ void init(int M, int N, int G_, int c_) { nM = M / BM; nN = N / BM; nwg = nM * nN; G = __builtin_amdgcn_readfirstlane(G_); c = __builtin_amdgcn_readfirstlane(c_); }
    __device__ bool next(int i, Unit& u) const {
        const long L = (long)i * G + c; if (L >= nwg) return false;
        int wgid = (int)L; { const int q = nwg / NXCD, r = nwg % NXCD, xcd = wgid % NXCD, off = wgid / NXCD; wgid = (xcd < r ? xcd * (q + 1) : r * (q + 1) + (xcd - r) * q) + off; }
        const int nig = WGM * nN, gid = wgid / nig, fm = gid * WGM, gsz = (nM - fm) < WGM ? (nM - fm) : WGM;
        u.pm = __builtin_amdgcn_readfirstlane(fm + ((wgid % nig) % gsz)); u.pn = __builtin_amdgcn_readfirstlane((wgid % nig) / gsz); return true;
    }
    __device__ __forceinline__ void a_ready(const Unit&) const {}
    __device__ __forceinline__ void done(const Unit&) const {}
};
template <class Epi, class Sched, bool ALIGN_EPI>
__device__ __forceinline__ void gemm_phase(LAS unsigned char* lds, const Gemm g, const Sched& S, const Epi& E) {
    const int tid = threadIdx.x, wid = __builtin_amdgcn_readfirstlane(tid >> 6), lane = tid & 63, wr = wid >> 2, wc = wid & 3, fr = lane & 15, fq = lane >> 4;
    int K = g.K; asm volatile("" : "+s"(K));
    const int nt = K / BK;
    unsigned voffA[2], voffB[2];
#pragma unroll
    for (int i = 0; i < 2; ++i) { int R, C; stage_rc(tid * 16 + i * 8192, R, C); const int Rb = E.perm() ? ((R & ~31) + perm32(R & 31)) : R;
        voffA[i] = (unsigned)(R * K + C) * 2u; voffB[i] = (unsigned)(Rb * K + C) * 2u; }
    const size_t kstep = (size_t)(BK * 2);
    const size_t hstep = (size_t)HALF * K * 2;
    const size_t tstep = 2 * hstep;
    const unsigned ldsw = (unsigned)wid * 1024u;
    const int aoff = lds_byte(wr * 64 + fr, fq * 8), boff = lds_byte(wc * 32 + fr, fq * 8);
#define PG8_SA(b, h) (((b) * 2 + (h)) * HTB)
#define PG8_SB(b, h) ((4 + (b) * 2 + (h)) * HTB)
#define PG8_STAGE(bufoff, gbase, voff) do { _Pragma("unroll") for (int _i = 0; _i < 2; ++_i) \
        __builtin_amdgcn_global_load_lds((const unsigned*)((const char*)(gbase) + (voff)[_i]), (LAS unsigned*)(lds + (bufoff) + ldsw + _i * 8192), 16, 0, 0); } while (0)
#define PG8_LDA(dst, b, h) do { _Pragma("unroll") for (int m = 0; m < 4; ++m) _Pragma("unroll") for (int k = 0; k < 2; ++k) dst[m][k] = *(const LAS bf16x8*)(lds + PG8_SA(b, h) + aoff + m * 2048 + k * 1024); } while (0)
#define PG8_LDB(dst, b, h) do { _Pragma("unroll") for (int n = 0; n < 2; ++n) _Pragma("unroll") for (int k = 0; k < 2; ++k) dst[n][k] = *(const LAS bf16x8*)(lds + PG8_SB(b, h) + boff + n * 2048 + k * 1024); } while (0)
#define PG8_MMA(ai, bj, At, Bt) do { __builtin_amdgcn_s_setprio(1); _Pragma("unroll") for (int m = 0; m < 4; ++m) _Pragma("unroll") for (int n = 0; n < 2; ++n) _Pragma("unroll") for (int k = 0; k < 2; ++k) \
        acc[ai][bj][m][n] = __builtin_amdgcn_mfma_f32_16x16x32_bf16(Bt[n][k], At[m][k], acc[ai][bj][m][n], 0, 0, 0); __builtin_amdgcn_s_setprio(0); } while (0)
#define PG8_WAIT_V(n) asm volatile("s_waitcnt vmcnt(" #n ")" ::: "memory")
#define PG8_WAIT_L(n) asm volatile("s_waitcnt lgkmcnt(" #n ")" ::: "memory")
#define PG8_BAR __builtin_amdgcn_s_barrier()
#define PG8_SCHED __builtin_amdgcn_sched_barrier(0)
    Unit cur, nxt; int ui = 0;
    if (!S.next(0, cur)) return;
    f32x4 acc[2][2][4][2];
#pragma unroll
    for (int a = 0; a < 2; ++a)
#pragma unroll
        for (int b = 0; b < 2; ++b)
#pragma unroll
            for (int m = 0; m < 4; ++m)
#pragma unroll
                for (int n = 0; n < 2; ++n) acc[a][b][m][n] = (f32x4){0.f, 0.f, 0.f, 0.f};
    bf16x8 At[4][2], B0[2][2], B1[2][2];
    const char* cA = (const char*)g.A + (size_t)cur.pm * tstep; const char* cB = (const char*)g.Bt + (size_t)cur.pn * tstep;
    PG8_STAGE(PG8_SB(0, 0), cB, voffB); PG8_STAGE(PG8_SB(0, 1), cB + hstep, voffB); PG8_STAGE(PG8_SA(0, 0), cA, voffA); PG8_STAGE(PG8_SA(0, 1), cA + hstep, voffA);
    if (wr == 1) PG8_BAR;
    PG8_WAIT_V(2); PG8_BAR;
    PG8_STAGE(PG8_SB(1, 0), cB + kstep, voffB); PG8_STAGE(PG8_SA(1, 0), cA + kstep, voffA); PG8_STAGE(PG8_SB(1, 1), cB + hstep + kstep, voffB);
    PG8_WAIT_V(6); PG8_BAR;
    for (;;) {
        const bool has_next = S.next(ui + 1, nxt);
        const char* nA = has_next ? (const char*)g.A + (size_t)nxt.pm * tstep : cA; const char* nB = has_next ? (const char*)g.Bt + (size_t)nxt.pn * tstep : cB;
        for (int t = 0; t < nt; t += 2) {
            const bool last = (t == nt - 2);
            const char* a1 = cA + (size_t)(t + 1) * kstep;
            const char* a2 = last ? nA : cA + (size_t)(t + 2) * kstep; const char* b2 = last ? nB : cB + (size_t)(t + 2) * kstep;
            const char* a3 = a2 + kstep; const char* b3 = b2 + kstep;
            PG8_LDB(B0, 0, 0); PG8_LDB(B1, 0, 1); PG8_SCHED; PG8_LDA(At, 0, 0); PG8_STAGE(PG8_SA(1, 1), a1 + hstep, voffA);
            PG8_WAIT_V(8); PG8_WAIT_L(0); PG8_BAR; PG8_MMA(0, 0, At, B0); PG8_MMA(0, 1, At, B1); PG8_BAR; PG8_SCHED;
            PG8_LDA(At, 0, 1); PG8_STAGE(PG8_SB(0, 0), b2, voffB); PG8_STAGE(PG8_SB(0, 1), b2 + hstep, voffB); PG8_STAGE(PG8_SA(0, 0), a2, voffA);
            PG8_WAIT_V(8); PG8_WAIT_L(0); PG8_BAR; PG8_MMA(1, 0, At, B0); PG8_MMA(1, 1, At, B1); PG8_BAR; PG8_SCHED;
            PG8_LDB(B0, 1, 0); PG8_LDB(B1, 1, 1); PG8_SCHED; PG8_LDA(At, 1, 0); PG8_STAGE(PG8_SA(0, 1), a2 + hstep, voffA);
            PG8_WAIT_V(8); PG8_WAIT_L(0); PG8_BAR; PG8_MMA(0, 0, At, B0); PG8_MMA(0, 1, At, B1); PG8_BAR; PG8_SCHED;
            PG8_LDA(At, 1, 1); PG8_STAGE(PG8_SB(1, 0), b3, voffB); PG8_STAGE(PG8_SB(1, 1), b3 + hstep, voffB); PG8_STAGE(PG8_SA(1, 0), a3, voffA);
            PG8_WAIT_V(8); PG8_WAIT_L(0); PG8_BAR; PG8_MMA(1, 0, At, B0); PG8_MMA(1, 1, At, B1); PG8_BAR; PG8_SCHED;
        }
        if constexpr (ALIGN_EPI) { if (wr == 0) PG8_BAR; }
        { int pm_ = cur.pm, pn_ = cur.pn, t_ = tid; asm volatile("" : "+s"(pm_), "+s"(pn_), "+v"(t_));
          const int l_ = t_ & 63, w_ = __builtin_amdgcn_readfirstlane(t_ >> 6); Unit cu; cu.pm = pm_; cu.pn = pn_;
          E(acc, cu, w_ >> 2, w_ & 3, l_ & 15, l_ >> 4); }
        if (!has_next) break;
#pragma unroll
        for (int a = 0; a < 2; ++a)
#pragma unroll
            for (int b = 0; b < 2; ++b)
#pragma unroll
                for (int m = 0; m < 4; ++m)
#pragma unroll
                    for (int n = 0; n < 2; ++n) acc[a][b][m][n] = (f32x4){0.f, 0.f, 0.f, 0.f};
        cur = nxt; cA = nA; cB = nB; ++ui;
        if constexpr (ALIGN_EPI) { if (wr == 1) PG8_BAR; }
    }
    PG8_WAIT_V(0);
    if constexpr (!ALIGN_EPI) { if (wr == 0) PG8_BAR; }
    PG8_BAR;
#undef PG8_SA
#undef PG8_SB
#undef PG8_STAGE
#undef PG8_LDA
#undef PG8_LDB
#undef PG8_MMA
#undef PG8_WAIT_V
#undef PG8_WAIT_L
#undef PG8_BAR
#undef PG8_SCHED
}
}
using pg8::Unit;
typedef f32x4 Acc[2][2][4][2];

struct Params { const float* in[27]; float* out; unsigned char* ws; int ph_lo, ph_hi; };
enum { I_X = 0, I_META, I_F1G, I_F1U, I_F1D, I_LN1G, I_LN1B, I_WIN, I_CONVW, I_CONVB, I_DTB, I_ALOG, I_DSKIP, I_SNG, I_FFB, I_QNG, I_WUQ, I_KVNG, I_WUKV, I_WOUT,
       I_LN2G, I_LN2B, I_F2G, I_F2U, I_F2D, I_LN3G, I_LN3B };

__device__ __forceinline__ const float* INP(const Params& p, int i) { asm volatile("" : "+s"(i)); return p.in[i]; }
struct Ctx {
    LAS unsigned char* lds; int tid, lane, wid, bid, G;
    const Params* p; unsigned char* ws;
    float* hmain; float* hmeta;
    template <class T> __device__ __forceinline__ T* W(size_t off) const { return (T*)(ws + off); }
    __device__ __forceinline__ float* hrow(int row) const { return row < RMAIN ? hmain + (size_t)row * DM : hmeta + (size_t)(row - RMAIN) * DM; }
};

template <class F>
__device__ __forceinline__ void meta_unit(const Ctx& c, const bf16_t* A, int lda, const bf16_t* Bt, int ldb, int K, int n0, int off2, const F& f) {
    const int fr = c.lane & 15, fq = c.lane >> 4;
    f32x4 a0 = zero_acc(), a1 = zero_acc();
    const int steps = K / 32;
    const bf16_t* ap = A + (size_t)fr * lda + fq * 8;
    const bf16_t* b0p = Bt + (size_t)(n0 + fr) * ldb + fq * 8;
    const bf16_t* b1p = Bt + (size_t)(n0 + off2 + fr) * ldb + fq * 8;
#pragma unroll 4
    for (int s = c.wid; s < steps; s += 8) {
        const bf16x8 av = *(const bf16x8*)(ap + s * 32);
        const bf16x8 b0 = *(const bf16x8*)(b0p + s * 32);
        const bf16x8 b1 = *(const bf16x8*)(b1p + s * 32);
        a0 = __builtin_amdgcn_mfma_f32_16x16x32_bf16(b0, av, a0, 0, 0, 0);
        a1 = __builtin_amdgcn_mfma_f32_16x16x32_bf16(b1, av, a1, 0, 0, 0);
    }
    LAS f32x4* red = (LAS f32x4*)c.lds;
    red[(c.wid * 2 + 0) * 64 + c.lane] = a0; red[(c.wid * 2 + 1) * 64 + c.lane] = a1;
    __syncthreads();
    if (c.wid == 0) {
        f32x4 s0 = red[c.lane], s1 = red[64 + c.lane];
#pragma unroll
        for (int w = 1; w < 8; ++w) { s0 += red[(w * 2) * 64 + c.lane]; s1 += red[(w * 2 + 1) * 64 + c.lane]; }
        f(fr, n0 + 4 * fq, s0, n0 + off2 + 4 * fq, s1);
    }
    __syncthreads();
}

struct EpiSwiglu {
    static constexpr bool PERM = true;
    bf16_t* act;
    __device__ __forceinline__ void operator()(const Acc& acc, const Unit& u, int wr, int wc, int fr, int fq) const {
        const int row0 = u.pm * 256 + wr * 64 + fr, col0 = u.pn * 128 + wc * 32 + 8 * fq;
#pragma unroll
        for (int ai = 0; ai < 2; ++ai)
#pragma unroll
            for (int m = 0; m < 4; ++m) {
                const f32x4 g0 = acc[ai][0][m][0], g1 = acc[ai][0][m][1], u0 = acc[ai][1][m][0], u1 = acc[ai][1][m][1];
                u32x4 w;
                w.x = pk2(silu_f(g0[0]) * u0[0], silu_f(g0[1]) * u0[1]); w.y = pk2(silu_f(g0[2]) * u0[2], silu_f(g0[3]) * u0[3]);
                w.z = pk2(silu_f(g1[0]) * u1[0], silu_f(g1[1]) * u1[1]); w.w = pk2(silu_f(g1[2]) * u1[2], silu_f(g1[3]) * u1[3]);
                *(u32x4*)(act + (size_t)(row0 + ai * 128 + m * 16) * DFF + col0) = w;
                asm volatile("" ::: "memory");
            }
    }
};
struct EpiResid {
    static constexpr bool PERM = true;
    float* h; float s; const float* base;
    __device__ __forceinline__ void operator()(const Acc& acc, const Unit& u, int wr, int wc, int fr, int fq) const {
        const int row0 = u.pm * 256 + wr * 64 + fr, col0 = u.pn * 256 + wc * 32 + 8 * fq;
#pragma unroll
        for (int ai = 0; ai < 2; ++ai)
#pragma unroll
            for (int m = 0; m < 4; ++m) {
                const size_t ro = (size_t)(row0 + ai * 128 + m * 16) * DM + col0;
                f32x4 b[2][2];
#pragma unroll
                for (int bj = 0; bj < 2; ++bj)
#pragma unroll
                    for (int n = 0; n < 2; ++n) b[bj][n] = *(const f32x4*)(base + ro + bj * 128 + n * 4);
#pragma unroll
                for (int bj = 0; bj < 2; ++bj)
#pragma unroll
                    for (int n = 0; n < 2; ++n) *(f32x4*)(h + ro + bj * 128 + n * 4) = b[bj][n] * ALPHA + acc[ai][bj][m][n] * s;
                if (m & 1) asm volatile("" ::: "memory");
            }
    }
};
struct InStore {
    bf16_t *Z, *XBC, *FQ, *FK, *CQ, *CKV; float* SMALL; bf16_t* FV;
    __device__ __forceinline__ void store4(int row, int c, f32x4 v) const {
        if (c < 2048) {
            bf16_t* dst;
            if (c < 512) dst = Z + (size_t)row * 512 + c;
            else if (c < 1280) dst = XBC + (size_t)row * 768 + (c - 512);
            else if (c < 1536) { dst = FQ + (size_t)row * 256 + (c - 1280); }
            else if (c < 1792) dst = FK + (size_t)row * 256 + (c - 1536);
            else dst = CQ + (size_t)row * 256 + (c - 1792);
            u32x2 w; w.x = pk2(v[0], v[1]); w.y = pk2(v[2], v[3]); *(u32x2*)dst = w;
        } else if (c < 2176) {
            u32x2 w; w.x = pk2(v[0], v[1]); w.y = pk2(v[2], v[3]); *(u32x2*)(CKV + (size_t)row * 128 + (c - 2048)) = w;
        } else if (c < 2240) {
            *(f32x4*)(SMALL + (size_t)row * 64 + (c - 2176)) = v;
        } else if (c >= 2304) {
            u32x2 w; w.x = pk2(v[0], v[1]); w.y = pk2(v[2], v[3]); *(u32x2*)(FV + (size_t)row * 256 + (c - 2304)) = w;
        }
    }
};
struct EpiIn {
    static constexpr bool PERM = true;
    unsigned char* ws;
    __device__ __forceinline__ void operator()(const Acc& acc, const Unit& u, int wr, int wc, int fr, int fq) const {
        const int pn = u.pn, row0 = u.pm * 256 + wr * 64 + fr, colw = wc * 32 + 8 * fq;
        if (pn != 8) {
            bf16_t* base; int pitch;
            if (pn < 2) { base = (bf16_t*)(ws + WS_Z) + pn * 256; pitch = 512; }
            else if (pn < 5) { base = (bf16_t*)(ws + WS_XBC) + (pn - 2) * 256; pitch = 768; }
            else if (pn == 5) { base = (bf16_t*)(ws + WS_FQ); pitch = 256; }
            else if (pn == 6) { base = (bf16_t*)(ws + WS_FK); pitch = 256; }
            else if (pn == 7) { base = (bf16_t*)(ws + WS_CQ); pitch = 256; }
            else { base = (bf16_t*)(ws + WS_FV); pitch = 256; }
            float* ssq = (float*)(ws + WS_SSQQ);
#pragma unroll
            for (int ai = 0; ai < 2; ++ai)
#pragma unroll
                for (int m = 0; m < 4; ++m) {
                    const int row = row0 + ai * 128 + m * 16;
                    bf16_t* rp = base + (size_t)row * pitch + colw;
                    float s = 0.f;
#pragma unroll
                    for (int bj = 0; bj < 2; ++bj) {
                        const f32x4 v0 = acc[ai][bj][m][0], v1 = acc[ai][bj][m][1];
                        u32x4 w; w.x = pk2(v0[0], v0[1]); w.y = pk2(v0[2], v0[3]); w.z = pk2(v1[0], v1[1]); w.w = pk2(v1[2], v1[3]);
                        *(u32x4*)(rp + bj * 128) = w;
                        s += v0[0] * v0[0] + v0[1] * v0[1] + v0[2] * v0[2] + v0[3] * v0[3] + v1[0] * v1[0] + v1[1] * v1[1] + v1[2] * v1[2] + v1[3] * v1[3];
                    }
                    if (pn == 7) { s += __shfl_xor(s, 16); s += __shfl_xor(s, 32); if (fq == 0) ssq[(size_t)row * 4 + wc] = s; }
                    asm volatile("" ::: "memory");
                }
        } else {
            bf16_t* ckv = (bf16_t*)(ws + WS_CKV); float* sm = (float*)(ws + WS_SMALL); float* ssq = (float*)(ws + WS_SSQKV);
#pragma unroll
            for (int ai = 0; ai < 2; ++ai)
#pragma unroll
                for (int m = 0; m < 4; ++m) {
                    const int row = row0 + ai * 128 + m * 16;
                    const f32x4 v0 = acc[ai][0][m][0], v1 = acc[ai][0][m][1];
                    u32x4 w; w.x = pk2(v0[0], v0[1]); w.y = pk2(v0[2], v0[3]); w.z = pk2(v1[0], v1[1]); w.w = pk2(v1[2], v1[3]);
                    *(u32x4*)(ckv + (size_t)row * 128 + colw) = w;
                    float s = v0[0] * v0[0] + v0[1] * v0[1] + v0[2] * v0[2] + v0[3] * v0[3] + v1[0] * v1[0] + v1[1] * v1[1] + v1[2] * v1[2] + v1[3] * v1[3];
                    s += __shfl_xor(s, 16); s += __shfl_xor(s, 32); if (fq == 0) ssq[(size_t)row * 4 + wc] = s;
                    if (wc < 2) { *(f32x4*)(sm + (size_t)row * 64 + colw) = acc[ai][1][m][0]; *(f32x4*)(sm + (size_t)row * 64 + colw + 4) = acc[ai][1][m][1]; }
                    asm volatile("" ::: "memory");
                }
        }
    }
};
struct UqStore {
    bf16_t* Qm; const float* ssq_q; const f32x2* rope;
    __device__ __forceinline__ void store(int row, int gb, int i0, f32x4 va, f32x4 vb) const {
        if (gb >= 384) return;
        const float sc = __builtin_amdgcn_rsqf(ssq4(ssq_q, row) * (1.f / 256.f) + EPS) * MLA_QS;
        va = va * sc; vb = vb * sc;
        if ((gb % 96) == 64) {
            const f32x2* rt = rope + (size_t)pos_of_row(row) * 16 + i0;
#pragma unroll
            for (int e = 0; e < 4; ++e) { const f32x2 cs = rt[e]; const float x1 = va[e], x2 = vb[e]; va[e] = x1 * cs.x - x2 * cs.y; vb[e] = x2 * cs.x + x1 * cs.y; }
        }
        u32x2 w; w.x = pk2(va[0], va[1]); w.y = pk2(va[2], va[3]); *(u32x2*)(Qm + (size_t)row * 384 + gb + i0) = w;
        w.x = pk2(vb[0], vb[1]); w.y = pk2(vb[2], vb[3]); *(u32x2*)(Qm + (size_t)row * 384 + gb + 16 + i0) = w;
    }
};
struct EpiUq {
    static constexpr bool PERM = false;
    UqStore st;
    __device__ __forceinline__ void operator()(const Acc& acc, const Unit& u, int wr, int wc, int fr, int fq) const {
        const int row0 = u.pm * 256 + wr * 64 + fr;
#pragma unroll
        for (int ai = 0; ai < 2; ++ai)
#pragma unroll
            for (int m = 0; m < 4; ++m)
                { for (int bj = 0; bj < 2; ++bj) st.store(row0 + ai * 128 + m * 16, u.pn * 256 + bj * 128 + wc * 32, 4 * fq, acc[ai][bj][m][0], acc[ai][bj][m][1]);
                  asm volatile("" ::: "memory"); }
    }
};
struct UkStore {
    bf16_t* Km; const float* ssq_kv;
    __device__ __forceinline__ void store4(int row, int c, f32x4 v) const {
        const float sc = __builtin_amdgcn_rsqf(ssq4(ssq_kv, row) * (1.f / 128.f) + EPS);
        u32x2 w; w.x = pk2(v[0] * sc, v[1] * sc); w.y = pk2(v[2] * sc, v[3] * sc);
        *(u32x2*)(Km + (size_t)row * 384 + (c >> 6) * 96 + (c & 63)) = w;
    }
};
struct EpiUk {
    static constexpr bool PERM = true;
    UkStore st; bf16_t* VtM;
    __device__ __forceinline__ void operator()(const Acc& acc, const Unit& u, int wr, int wc, int fr, int fq) const {
        const int row0 = u.pm * 256 + wr * 64 + fr, col0 = wc * 32 + 8 * fq;
        const bool isv = u.pn == 1;
        const int kc0 = isv ? col0 : (col0 >> 6) * 96 + (col0 & 63);
        bf16_t* dstb = isv ? VtM : st.Km; const int pitch = isv ? 256 : 384, bjoff = isv ? 128 : 192;
#pragma unroll
        for (int ai = 0; ai < 2; ++ai)
#pragma unroll
            for (int m = 0; m < 4; ++m) {
                const int row = row0 + ai * 128 + m * 16;
                const float sc = __builtin_amdgcn_rsqf(ssq4(st.ssq_kv, row) * (1.f / 128.f) + EPS);
                bf16_t* rp = dstb + (size_t)row * pitch + kc0;
#pragma unroll
                for (int bj = 0; bj < 2; ++bj) {
                    const f32x4 v0 = acc[ai][bj][m][0] * sc, v1 = acc[ai][bj][m][1] * sc;
                    u32x4 w; w.x = pk2(v0[0], v0[1]); w.y = pk2(v0[2], v0[3]); w.z = pk2(v1[0], v1[1]); w.w = pk2(v1[2], v1[3]);
                    *(u32x4*)(rp + bj * bjoff) = w;
                }
                asm volatile("" ::: "memory");
            }
    }
};

struct WMap { const float* base; const float* base2; const float* kscale; bf16_t* dst; int ld, K, N, kind; };
__device__ __forceinline__ const float* wmap_col(const WMap& m, int n) {
    switch (m.kind) {
        case 0: return m.base + n;
        case 1: { const int t = n >> 8, w = n & 255; return w < 128 ? m.base + 128 * t + w : m.base2 + 128 * t + (w - 128); }
        case 2: {
            int s;
            if (n < 1280) s = n; else if (n < 1536) s = 1288 + (n - 1280); else if (n < 1792) s = 1544 + (n - 1536); else if (n < 2048) s = 2060 + (n - 1792);
            else if (n < 2176) s = 2316 + (n - 2048); else if (n < 2208) s = 2444 + (n - 2176); else if (n < 2216) s = 1280 + (n - 2208); else if (n < 2220) s = 2056 + (n - 2216); else if (n < 2304) return nullptr; else s = 1800 + (n - 2304);
            return m.base + s; }
        case 4: return n < 384 ? m.base + n : nullptr;
        default: return n < 256 ? m.base + (n >> 6) * 128 + (n & 63) : m.base + ((n - 256) >> 6) * 128 + 64 + (n & 63);
    }
}
__device__ __forceinline__ void transpose_item(const WMap& m, int item, LAS float* scr, int lane) {
    const int nblk = m.N / 32, kb = item / nblk, nb = item % nblk, k0 = 64 * kb, n0 = 32 * nb;
    const float* cp = wmap_col(m, n0 + (lane & 31));
    const float cs = (m.kind == 2 && n0 >= 1280 && n0 < 1536) ? FOX_QS : 1.f;
    float wv[32];
#pragma unroll
    for (int i = 0; i < 32; ++i) { const int kk = 2 * i + (lane >> 5); wv[i] = cp ? cp[(size_t)(k0 + kk) * m.ld] : 0.f; }
#pragma unroll
    for (int i = 0; i < 32; ++i) { const int kk = 2 * i + (lane >> 5); float v = wv[i] * cs; if (cp && m.kscale) v *= m.kscale[k0 + kk]; scr[kk * 33 + (lane & 31)] = v; }
    LDS_WAIT();
    const int c = lane & 7;
#pragma unroll
    for (int j = 0; j < 4; ++j) { const int n = (lane >> 3) + 8 * j; const LAS float* s = scr + (8 * c) * 33 + n;
        u32x4 o; o.x = pk2(s[0 * 33], s[1 * 33]); o.y = pk2(s[2 * 33], s[3 * 33]); o.z = pk2(s[4 * 33], s[5 * 33]); o.w = pk2(s[6 * 33], s[7 * 33]);
        *(u32x4*)(m.dst + (size_t)(n0 + n) * m.K + k0 + 8 * c) = o; }
    LDS_WAIT();
}
__device__ __forceinline__ void convert_weights(const Ctx& c, int l) {
    const Params& p = *c.p; (void)p;
    LAS float* scr = (LAS float*)(c.lds + c.wid * 8704);
    const int gw = c.bid * 8 + c.wid, NGW = c.G * 8;
    constexpr int CNT[8] = {2816, 1408, 2816, 1408, 1280, 512, 64, 32};
    constexpr int TOTAL = 2816 + 1408 + 2816 + 1408 + 1280 + 512 + 64 + 32;
    for (int it = gw; it < TOTAL; it += NGW) {
        int r = it, mi = 0;
#pragma unroll
        for (int i = 0; i < 7; ++i) { if (mi == i && r >= CNT[i]) { r -= CNT[i]; mi = i + 1; } }
        WMap m;
        switch (mi) {
            case 0: m = WMap{INP(p, I_F1G) + (size_t)l * DM * DFF, INP(p, I_F1U) + (size_t)l * DM * DFF, nullptr, c.W<bf16_t>(WS_WGU1), DFF, DM, 2 * DFF, 1}; break;
            case 1: m = WMap{INP(p, I_F1D) + (size_t)l * DFF * DM, nullptr, nullptr, c.W<bf16_t>(WS_WD1), DM, DFF, DM, 0}; break;
            case 2: m = WMap{INP(p, I_F2G) + (size_t)l * DM * DFF, INP(p, I_F2U) + (size_t)l * DM * DFF, nullptr, c.W<bf16_t>(WS_WGU2), DFF, DM, 2 * DFF, 1}; break;
            case 3: m = WMap{INP(p, I_F2D) + (size_t)l * DFF * DM, nullptr, nullptr, c.W<bf16_t>(WS_WD2), DM, DFF, DM, 0}; break;
            case 4: m = WMap{INP(p, I_WIN) + (size_t)l * DM * NIN, nullptr, nullptr, c.W<bf16_t>(WS_WIN), NIN, DM, 2560, 2}; break;
            case 5: m = WMap{INP(p, I_WOUT) + (size_t)l * DM * DM, nullptr, nullptr, c.W<bf16_t>(WS_WOUT), DM, DM, DM, 0}; break;
            case 6: m = WMap{INP(p, I_WUQ) + (size_t)l * 256 * 384, nullptr, INP(p, I_QNG) + l * 256, c.W<bf16_t>(WS_WUQ), 384, 256, 512, 4}; break;
            default: m = WMap{INP(p, I_WUKV) + (size_t)l * 128 * 512, nullptr, INP(p, I_KVNG) + l * 128, c.W<bf16_t>(WS_WUKV), 512, 128, 512, 5}; break;
        }
        transpose_item(m, r, scr, c.lane);
    }
}

__device__ __forceinline__ void ln_rows(const Ctx& c, const float* g, const float* bta, bf16_t* hb, int nrows) {
    const int gw = c.bid * 8 + c.wid, NGW = c.G * 8;
    f32x4 gv[4], bv[4];
#pragma unroll
    for (int j = 0; j < 4; ++j) { gv[j] = ((const f32x4*)g)[c.lane + 64 * j]; bv[j] = ((const f32x4*)bta)[c.lane + 64 * j]; }
    for (int row = gw; row < nrows; row += NGW) {
        f32x4* xr = (f32x4*)c.hrow(row) + c.lane;
        if (row + NGW < nrows) __builtin_prefetch((const void*)((const f32x4*)c.hrow(row + NGW) + c.lane), 0, 0);
        f32x4 v[4]; float s = 0.f;
#pragma unroll
        for (int j = 0; j < 4; ++j) { v[j] = xr[64 * j]; s += (v[j][0] + v[j][1]) + (v[j][2] + v[j][3]); }
        const float mean = wave_sum(s) * (1.f / DM); float s2 = 0.f;
#pragma unroll
        for (int j = 0; j < 4; ++j) { v[j] = v[j] - mean; s2 += (v[j][0] * v[j][0] + v[j][1] * v[j][1]) + (v[j][2] * v[j][2] + v[j][3] * v[j][3]); }
        const float rstd = 1.f / sqrtf(wave_sum(s2) * (1.f / DM) + EPS);
#pragma unroll
        for (int j = 0; j < 4; ++j) {
            const f32x4 o = v[j] * rstd * gv[j] + bv[j];
            xr[64 * j] = o;
            if (hb) { u32x2 w; w.x = pk2(o[0], o[1]); w.y = pk2(o[2], o[3]); *((u32x2*)(hb + (size_t)row * DM) + c.lane + 64 * j) = w; }
        }
    }
}

template <int DQK, bool BIAS>
__device__ __forceinline__ void attn_item(const Ctx& c, const bf16_t* Qb, const bf16_t* Kb, int ld, const bf16_t* Vb, int ldv, const float* bias, bf16_t* mix, int ocol, int b, int j) {
    constexpr int KP = DQK + 8, NS = DQK / 32, KCH = DQK / 8, KPT = 128 * KCH / 512;
    constexpr int VP = 136;
    constexpr int KB_BYTES = 128 * KP * 2, VB_BYTES = 64 * VP * 2;
    LAS unsigned char* lds = c.lds;
    const int tid = c.tid, lane = c.lane, w = c.wid, fr = lane & 15, fq = lane >> 4;
    const int nq = j == 0 ? 16 : 128, ntiles = j + 1;
    const int qpos0 = j == 0 ? 0 : NMETA + 128 * (j - 1);
    const bool active = (16 * w) < nq;
    bf16x8 qf[NS];
    if (active) {
        const bf16_t* qp = Qb + (size_t)row_of(b, qpos0 + 16 * w + fr) * ld + fq * 8;
#pragma unroll
        for (int s = 0; s < NS; ++s) qf[s] = *(const bf16x8*)(qp + s * 32);
    }
    u32x4 kreg[KPT], vreg[2]; float breg = 0.f;
    auto load_tile = [&](int t) {
        const int pos0 = t == 0 ? 0 : NMETA + 128 * (t - 1), nk = t == 0 ? 16 : 128;
#pragma unroll
        for (int i = 0; i < KPT; ++i) { const int q = tid + 512 * i, r = q / KCH, cc = q % KCH;
            kreg[i] = (u32x4){0u, 0u, 0u, 0u};
            if (r < nk) kreg[i] = *(const u32x4*)(Kb + (size_t)row_of(b, pos0 + r) * ld + cc * 8); }
#pragma unroll
        for (int i = 0; i < 2; ++i) { const int q = tid + 512 * i, r = q & 127, cc = q >> 7;
            vreg[i] = (u32x4){0u, 0u, 0u, 0u};
            if (r < nk) vreg[i] = *(const u32x4*)(Vb + (size_t)row_of(b, pos0 + r) * ldv + cc * 8); }
        if (BIAS && tid < 128) breg = tid < nk ? bias[pos0 + tid] : 0.f;
    };
    auto store_tile = [&](int buf) {
        LAS unsigned char* kb = lds + buf * KB_BYTES; LAS unsigned char* vb = lds + 2 * KB_BYTES + buf * VB_BYTES;
#pragma unroll
        for (int i = 0; i < KPT; ++i) { const int q = tid + 512 * i, r = q / KCH, cc = q % KCH; *(LAS u32x4*)(kb + (r * KP + cc * 8) * 2) = kreg[i]; }
#pragma unroll
        for (int i = 0; i < 2; ++i) { const int q = tid + 512 * i, r = q & 127, cc = q >> 7; LAS bf16_t* vp = (LAS bf16_t*)vb + (cc * 8) * VP + r;
            vp[0] = (bf16_t)(vreg[i].x & 0xffffu); vp[VP] = (bf16_t)(vreg[i].x >> 16); vp[2 * VP] = (bf16_t)(vreg[i].y & 0xffffu); vp[3 * VP] = (bf16_t)(vreg[i].y >> 16);
            vp[4 * VP] = (bf16_t)(vreg[i].z & 0xffffu); vp[5 * VP] = (bf16_t)(vreg[i].z >> 16); vp[6 * VP] = (bf16_t)(vreg[i].w & 0xffffu); vp[7 * VP] = (bf16_t)(vreg[i].w >> 16); }
        if (BIAS && tid < 128) ((LAS float*)(lds + 2 * KB_BYTES + 2 * VB_BYTES))[buf * 128 + tid] = breg;
    };
    float m_run = -INFINITY, l_run = 0.f;
    f32x4 o[4];
#pragma unroll
    for (int dg = 0; dg < 4; ++dg) o[dg] = zero_acc();
    const int q_local = 16 * w + fr;
    auto compute = [&](int buf, auto ngc, int mode  ) {
        constexpr int NG = decltype(ngc)::value;
        const LAS unsigned char* kb = lds + buf * KB_BYTES; const LAS unsigned char* vb = lds + 2 * KB_BYTES + buf * VB_BYTES;
        const LAS float* bb = (const LAS float*)(lds + 2 * KB_BYTES + 2 * VB_BYTES) + buf * 128;
        f32x4 sacc[NG];
#pragma unroll
        for (int g = 0; g < NG; ++g) {
            sacc[g] = BIAS ? *(const LAS f32x4*)(bb + 16 * g + 4 * fq) : zero_acc();
#pragma unroll
            for (int s = 0; s < NS; ++s) { const bf16x8 kf = *(const LAS bf16x8*)(kb + ((16 * g + fr) * KP + s * 32 + fq * 8) * 2);
                sacc[g] = __builtin_amdgcn_mfma_f32_16x16x32_bf16(kf, qf[s], sacc[g], 0, 0, 0); }
        }
        if (mode != 0) {
            const int lim = mode == 1 ? q_local : 15;
#pragma unroll
            for (int g = 0; g < NG; ++g)
#pragma unroll
                for (int e = 0; e < 4; ++e) if (16 * g + 4 * fq + e > lim) sacc[g][e] = -INFINITY;
        }
        float mx = sacc[0][0];
#pragma unroll
        for (int g = 0; g < NG; ++g)
#pragma unroll
            for (int e = 0; e < 4; ++e) mx = fmaxf(mx, sacc[g][e]);
        mx = fmaxf(mx, __shfl_xor(mx, 16)); mx = fmaxf(mx, __shfl_xor(mx, 32));
        const float m_new = fmaxf(m_run, mx);
        const float alpha = fast_exp2(m_run - m_new);
        m_run = m_new;
        float ps = 0.f;
#pragma unroll
        for (int g = 0; g < NG; ++g)
#pragma unroll
            for (int e = 0; e < 4; ++e) { const float pv = fast_exp2(sacc[g][e] - m_new); sacc[g][e] = pv; ps += pv; }
        l_run = l_run * alpha + ps;
#pragma unroll
        for (int dg = 0; dg < 4; ++dg) o[dg] = o[dg] * alpha;
#pragma unroll
        for (int sl = 0; sl < NG / 2; ++sl) {
            f32x4 pa = sacc[2 * sl], pb = sacc[2 * sl + 1];
            u32x4 pw; pw.x = pk2(pa[0], pa[1]); pw.y = pk2(pa[2], pa[3]); pw.z = pk2(pb[0], pb[1]); pw.w = pk2(pb[2], pb[3]);
            const bf16x8 pf = __builtin_bit_cast(bf16x8, pw);
#pragma unroll
            for (int dg = 0; dg < 4; ++dg) {
                const LAS unsigned char* vp = vb + ((16 * dg + fr) * VP + 32 * sl + 4 * fq) * 2;
                const u32x2 lo = *(const LAS u32x2*)vp, hi = *(const LAS u32x2*)(vp + 32);
                const u32x4 vv = {lo.x, lo.y, hi.x, hi.y};
                o[dg] = __builtin_amdgcn_mfma_f32_16x16x32_bf16(__builtin_bit_cast(bf16x8, vv), pf, o[dg], 0, 0, 0);
            }
        }
    };
    load_tile(0); store_tile(0); __syncthreads();
    for (int t = 0; t < ntiles; ++t) {
        if (t + 1 < ntiles) load_tile(t + 1);
        if (active) {
            if (t == 0) compute(0, std::integral_constant<int, 2>{}, j == 0 ? 1 : 2);
            else compute(t & 1, std::integral_constant<int, 8>{}, t == j ? 1 : 0);
        }
        if (t + 1 < ntiles) store_tile((t + 1) & 1);
        __syncthreads();
    }
#ifdef CK_TEST
    if (active && (j > 0 || b == 0)) {
        const int qpos = qpos0 + q_local; const int row = row_of(b, qpos);
        bf16_t* op = mix + (size_t)row * DM + ocol + 4 * fq;
#pragma unroll
        for (int dg = 0; dg < 4; ++dg) { float v[4];
#pragma unroll
            for (int e = 0; e < 4; ++e) { const int d = 16 * dg + 4 * fq + e; v[e] = bf2f(Vb[(size_t)row * ldv + d]); }
            u32x2 wv; wv.x = pk2(v[0], v[1]); wv.y = pk2(v[2], v[3]); *(u32x2*)(op + 16 * dg) = wv; }
    }
    if (0) {
        float l = l_run; l += __shfl_xor(l, 16); l += __shfl_xor(l, 32);
#else
    if (active && (j > 0 || b == 0)) {
        float l = l_run; l += __shfl_xor(l, 16); l += __shfl_xor(l, 32);
#endif
        const float rl = 1.f / l;
        bf16_t* op = mix + (size_t)row_of(b, qpos0 + q_local) * DM + ocol + 4 * fq;
#pragma unroll
        for (int dg = 0; dg < 4; ++dg) { u32x2 wv; wv.x = pk2(o[dg][0] * rl, o[dg][1] * rl); wv.y = pk2(o[dg][2] * rl, o[dg][3] * rl); *(u32x2*)(op + 16 * dg) = wv; }
    }
}

__device__ __forceinline__ void ssd_item_seq(const Ctx& c, int b, int h, int ph, int l) {
    const Params& p = *c.p; (void)p;
    constexpr int O_B = 0, O_C = 32768, O_X = 65536, O_Z = 73728, O_DT = 81920;
    LAS unsigned char* lds = c.lds;
    const int tid = c.tid, g = h >> 2, pl = tid >> 4, l16 = tid & 15, ns = 4 * l16;
    const bf16_t* Cn = c.W<bf16_t>(WS_CN) + g * 64; const bf16_t* Bn = c.W<bf16_t>(WS_BN) + g * 64;
    const bf16_t* XC = c.W<bf16_t>(WS_XC) + h * 64 + 32 * ph; const bf16_t* Z = c.W<bf16_t>(WS_Z) + h * 64 + 32 * ph; const float* dtv = c.W<float>(WS_DTV) + h;
    bf16_t* mix = c.W<bf16_t>(WS_HB) + h * 64 + 32 * ph + pl;
    const float Ah = -__expf(INP(p, I_ALOG)[l * 8 + h]) * LOG2E, Dh = INP(p, I_DSKIP)[l * 8 + h];
    u32x4 rB[2], rC[2], rX, rZ; float rD = 0.f;
    auto load_chunk = [&](int ch) {
        const int pos0 = ch == 0 ? 0 : NMETA + 128 * (ch - 1), nv = ch == 0 ? 16 : 128;
#pragma unroll
        for (int i = 0; i < 2; ++i) { const int q = tid + 512 * i, r = q >> 3, cc = q & 7; rB[i] = (u32x4){0u, 0u, 0u, 0u}; rC[i] = rB[i];
            if (r < nv) { const size_t ro = (size_t)row_of(b, pos0 + r) * 128 + cc * 8; rB[i] = *(const u32x4*)(Bn + ro); rC[i] = *(const u32x4*)(Cn + ro); } }
        { const int r = tid >> 2, cc = tid & 3; rX = (u32x4){0u, 0u, 0u, 0u}; rZ = rX;
            if (r < nv) { const size_t ro = (size_t)row_of(b, pos0 + r) * 512 + cc * 8; rX = *(const u32x4*)(XC + ro); rZ = *(const u32x4*)(Z + ro); } }
        if (tid < 128) rD = tid < nv ? dtv[(size_t)row_of(b, pos0 + tid) * 8] : 0.f;
    };
    auto store_chunk = [&]() {
#pragma unroll
        for (int i = 0; i < 2; ++i) { const int q = tid + 512 * i;
            LAS f32x4* db = (LAS f32x4*)(lds + O_B + q * 32); LAS f32x4* dc = (LAS f32x4*)(lds + O_C + q * 32);
            db[0] = (f32x4){bf2f(rB[i].x & 0xffffu), bf2f(rB[i].x >> 16), bf2f(rB[i].y & 0xffffu), bf2f(rB[i].y >> 16)}; db[1] = (f32x4){bf2f(rB[i].z & 0xffffu), bf2f(rB[i].z >> 16), bf2f(rB[i].w & 0xffffu), bf2f(rB[i].w >> 16)};
            dc[0] = (f32x4){bf2f(rC[i].x & 0xffffu), bf2f(rC[i].x >> 16), bf2f(rC[i].y & 0xffffu), bf2f(rC[i].y >> 16)}; dc[1] = (f32x4){bf2f(rC[i].z & 0xffffu), bf2f(rC[i].z >> 16), bf2f(rC[i].w & 0xffffu), bf2f(rC[i].w >> 16)}; }
        *(LAS u32x4*)(lds + O_X + tid * 16) = rX; *(LAS u32x4*)(lds + O_Z + tid * 16) = rZ;
        if (tid < 128) ((LAS float*)(lds + O_DT))[tid] = rD;
    };
    f32x4 S = {0.f, 0.f, 0.f, 0.f};
#define DPP_ADD(y, ctrl) y += __builtin_bit_cast(float, __builtin_amdgcn_update_dpp(0, __builtin_bit_cast(int, y), ctrl, 0xf, 0xf, true))
    load_chunk(0); store_chunk(); __syncthreads();
    for (int ch = 0; ch < 17; ++ch) {
        if (ch + 1 < 17) load_chunk(ch + 1);
        const int pos0 = ch == 0 ? 0 : NMETA + 128 * (ch - 1), nv = ch == 0 ? 16 : 128;
        const bool wr = (ch > 0 || b == 0);
        for (int i0 = 0; i0 < nv; i0 += 16) {
            float ykeep = 0.f;
#pragma unroll
            for (int k = 0; k < 16; ++k) {
                const int i = i0 + k;
                const float dt = ((const LAS float*)(lds + O_DT))[i];
                const float x = bf2f(((const LAS bf16_t*)(lds + O_X))[i * 32 + pl]);
                const f32x4 bv = *(const LAS f32x4*)(lds + O_B + (i * 64 + ns) * 4), cv = *(const LAS f32x4*)(lds + O_C + (i * 64 + ns) * 4);
                const float a = fast_exp2(dt * Ah), dx = dt * x;
                S = S * a + bv * dx;
                const f32x4 cs = cv * S;
                float y = (cs[0] + cs[1]) + (cs[2] + cs[3]);
                DPP_ADD(y, 0xB1); DPP_ADD(y, 0x4E); DPP_ADD(y, 0x141); DPP_ADD(y, 0x140);
                ykeep = (l16 == k) ? y : ykeep;
            }
            if (wr) { const int t = i0 + l16;
                const float x = bf2f(((const LAS bf16_t*)(lds + O_X))[t * 32 + pl]), zz = bf2f(((const LAS bf16_t*)(lds + O_Z))[t * 32 + pl]);
                const float o = (ykeep + Dh * x) * silu_f(zz); mix[(size_t)row_of(b, pos0 + t) * DM] = (bf16_t)(pk2(o, 0.f) & 0xffffu); }
        }
        __syncthreads();
        if (ch + 1 < 17) store_chunk();
        __syncthreads();
    }
#undef DPP_ADD
}

#define XB_TMO      128
#define XB_XCNT(j)  (256  + 64 * (j))
#define XB_XSUB(j)  (1280 + 64 * (j))
#define XB_XGEN(j)  (2304 + 64 * (j))
#define XB_TOP      3328
#define XB_TOPGEN   3392
#define XCD_BAR_WORDS 3456
#define XB_SPIN_CAP (1u << 18)

__device__ __forceinline__ unsigned xb_ld(unsigned* p)              { return __hip_atomic_load(p, __ATOMIC_RELAXED, __HIP_MEMORY_SCOPE_AGENT); }
__device__ __forceinline__ unsigned xb_add(unsigned* p, unsigned v) { return __hip_atomic_fetch_add(p, v, __ATOMIC_RELAXED, __HIP_MEMORY_SCOPE_AGENT); }
__device__ __forceinline__ unsigned xb_xcc_id() { return (unsigned)__builtin_amdgcn_s_getreg((3 << 11) | 20) & 0xFu; }
#define XB_SPIN(cond, bar) do { unsigned _sp = 0; while (cond) { __builtin_amdgcn_s_sleep(1); \
    if ((++_sp & 255u) == 0u) { if (xb_ld(&(bar)[XB_TMO])) break; if (_sp > XB_SPIN_CAP) { atomicAdd(&(bar)[XB_TMO], 1u); break; } } } } while (0)

struct XcdBarrier {
    unsigned* bar; unsigned x;
    volatile LAS unsigned* st;
};

__device__ __forceinline__ XcdBarrier xcd_barrier_post(unsigned* bar, volatile LAS unsigned* st) {
    XcdBarrier b; b.bar = bar; b.x = xb_xcc_id(); b.st = st;
    if (threadIdx.x == 0) (void)xb_add(&bar[XB_XCNT(b.x)], 1u);
    return b;
}
__device__ __forceinline__ void xcd_barrier_complete(unsigned* bar, unsigned x, unsigned& nloc, unsigned& nx) {
    const unsigned G = gridDim.x * gridDim.y * gridDim.z;
    unsigned sum, cnt, mine, sp = 0u;
    for (;;) {
        sum = 0u; cnt = 0u; mine = 0u;
#pragma unroll
        for (unsigned j = 0; j < 16; ++j) { const unsigned c = xb_ld(&bar[XB_XCNT(j)]); sum += c; cnt += (c > 0u) ? 1u : 0u; mine = (j == x) ? c : mine; }
        if (sum == G) break;
        __builtin_amdgcn_s_sleep(1);
        if ((++sp & 255u) == 0u) { if (xb_ld(&bar[XB_TMO])) break; if (sp > XB_SPIN_CAP) { atomicAdd(&bar[XB_TMO], 1u); break; } }
    }
    nloc = mine > 0u ? mine : 1u; nx = cnt > 0u ? cnt : 1u;
}

__device__ __forceinline__ void xcd_barrier(const XcdBarrier& b) {
    asm volatile("s_waitcnt vmcnt(0)" ::: "memory");
    __syncthreads();
    if (threadIdx.x == 0) {
        unsigned* bar = b.bar;
        __builtin_amdgcn_s_waitcnt(0);
        unsigned nloc = b.st[0], nx = b.st[1];
        if (nloc == 0u) { xcd_barrier_complete(bar, b.x, nloc, nx); b.st[0] = nloc; b.st[1] = nx; }
        const unsigned old = xb_add(&bar[XB_XSUB(b.x)], 1u);
        const unsigned gen = old / nloc;
        if (old + 1u == (gen + 1u) * nloc) {
            __builtin_amdgcn_fence(__ATOMIC_RELEASE, "agent");
            asm volatile("s_waitcnt vmcnt(0)" ::: "memory");
            const unsigned og = xb_add(&bar[XB_TOP], 1u);
            const unsigned tg = og / nx;
            if (og + 1u == (tg + 1u) * nx) xb_add(&bar[XB_TOPGEN], 1u);
            else XB_SPIN(xb_ld(&bar[XB_TOPGEN]) == tg, bar);
            __builtin_amdgcn_fence(__ATOMIC_ACQUIRE, "agent");
            xb_add(&bar[XB_XGEN(b.x)], 1u);
            asm volatile("s_waitcnt vmcnt(0)" ::: "memory");
        } else {
            XB_SPIN(xb_ld(&bar[XB_XGEN(b.x)]) == gen, bar);
            __builtin_amdgcn_fence(__ATOMIC_ACQUIRE, "agent");
            asm volatile("s_waitcnt vmcnt(0)" ::: "memory");
        }
    }
    __syncthreads();
}

enum { EK_SWIGLU = 0, EK_RESID = 1, EK_IN = 2, EK_UQ = 3, EK_UKV = 4 };
struct EpiAny {
    int kind; unsigned char* ws; float* hmain; float s; const float* base;
    __device__ __forceinline__ bool perm() const { return kind != EK_UQ; }
    __device__ __forceinline__ void operator()(const Acc& acc, const Unit& u, int wr, int wc, int fr, int fq) const {
        if (kind == EK_SWIGLU) { EpiSwiglu{(bf16_t*)(ws + WS_ACT)}(acc, u, wr, wc, fr, fq); }
        else if (kind == EK_RESID) { EpiResid{hmain, s, base}(acc, u, wr, wc, fr, fq); }
        else if (kind == EK_IN) { EpiIn{ws}(acc, u, wr, wc, fr, fq); }
        else if (kind == EK_UQ) { EpiUq{UqStore{(bf16_t*)(ws + WS_QM), (const float*)(ws + WS_SSQQ), (const f32x2*)(ws + WS_ROPE)}}(acc, u, wr, wc, fr, fq); }
        else { EpiUk{UkStore{(bf16_t*)(ws + WS_KM), (const float*)(ws + WS_SSQKV)}, (bf16_t*)(ws + WS_VM)}(acc, u, wr, wc, fr, fq); }
    }
};
struct GDesc { const bf16_t* A; const bf16_t* Bt; int M, N, K, kind, coff; float s; };
struct MDesc { const bf16_t* A; const bf16_t* Bt; int lda, ldb, K, n0, off2, kind; float s; };
enum { MK_SWIGLU = 0, MK_RESID = 1, MK_IN = 2, MK_UQ = 3, MK_UKV = 4 };

template <int MASK>
__global__ void __launch_bounds__(512, 2) mk_fwd(Params prm) {
    extern __shared__ __attribute__((aligned(16))) unsigned char lds_raw[];
    const Params& p = prm;
#if MK_LAUNCHES == 1
    volatile LAS unsigned* xb_st = (volatile LAS unsigned*)((LAS unsigned char*)lds_raw + 133632);
    if (threadIdx.x < 2) xb_st[threadIdx.x] = 0u;
    __syncthreads();
    const XcdBarrier xbar = xcd_barrier_post((unsigned*)(prm.ws + WS_BAR), xb_st);
#endif
#ifdef NO_LOOP
    { int ph = p.ph_lo;
#else
    for (int ph = p.ph_lo; ph < p.ph_hi; ++ph) {
#endif
        Ctx c;
#define FRESH() do { unsigned char* ws_ = prm.ws; float* out_ = prm.out; int tid_ = threadIdx.x; unsigned ldsb = 0u; \
          asm volatile("" : "+s"(ws_), "+s"(out_), "+v"(tid_), "+s"(ldsb)); \
          c.lds = (LAS unsigned char*)lds_raw + ldsb; \
          c.tid = tid_; c.lane = tid_ & 63; c.wid = __builtin_amdgcn_readfirstlane(tid_ >> 6); c.bid = blockIdx.x; c.G = gridDim.x; \
          c.p = &prm; c.ws = ws_; c.hmain = out_; c.hmeta = (float*)(ws_ + WS_HMETA); } while (0)
        FRESH();
        const int l = ph == 0 ? 0 : (ph - 1) / 12, k = ph == 0 ? -1 : (ph - 1) % 12;
        const bool lastffn = (l == 1 && k >= 9);
#ifdef DUP_K
        const int nrep = (k == DUP_K) ? 2 : 1;
#else
        const int nrep = 1;
#endif
        for (int rep = 0; rep < nrep; ++rep) {
        if (rep > 0) { cg::this_grid().sync(); if (blockIdx.x == 0 && threadIdx.x == 0) ((unsigned*)(prm.ws + WS_CTL))[0] = 0u; cg::this_grid().sync(); FRESH(); }

        if (EN(1)) {
#ifdef SSD_T6
            const int ng = (k == 0 || k == 9 || k == 1 || k == 10 || k == 7 || k == 3) ? 1 : 0;
#else
            const int ng = (k == 0 || k == 9 || k == 1 || k == 10 || k == 7 || k == 3) ? 1 : (k == 4 ? 2 : 0);
#endif
            for (int gi = 0; gi < ng; ++gi) {
                FRESH();
                GDesc d;
                bf16_t* HB = c.W<bf16_t>(WS_HB); bf16_t* ACT = c.W<bf16_t>(WS_ACT);
                if (k == 0 || k == 9) d = GDesc{HB, c.W<bf16_t>(k == 0 ? WS_WGU1 : WS_WGU2), RMAIN, 2 * DFF, DM, EK_SWIGLU, 0, 0.f};
                else if (k == 1 || k == 10) d = GDesc{ACT, c.W<bf16_t>(k == 1 ? WS_WD1 : WS_WD2), RMAIN, DM, DFF, EK_RESID, 0, 0.5f};
                else if (k == 7) d = GDesc{HB, c.W<bf16_t>(WS_WOUT), RMAIN, DM, DM, EK_RESID, 0, 1.f};
                else if (k == 3) d = GDesc{HB, c.W<bf16_t>(WS_WIN), RMAIN, 2560, DM, EK_IN, 0, 0.f};
                else if (gi == 0) d = GDesc{c.W<bf16_t>(WS_CQ), c.W<bf16_t>(WS_WUQ), RMAIN, 512, 256, EK_UQ, 0, 0.f};
                else d = GDesc{c.W<bf16_t>(WS_CKV), c.W<bf16_t>(WS_WUKV), RMAIN, 512, 128, EK_UKV, 128, 0.f};
                pg8::Gemm g{d.A, d.Bt, d.M, d.N, d.K}; pg8::StaticOrder S; S.init(d.M, d.N, c.G, (c.bid + c.G - d.coff) % c.G);
                const bool firstffn = (l == 0 && k == 1);
                EpiAny E{d.kind, c.ws, c.hmain, d.s, firstffn ? INP(p, I_X) : (const float*)c.hmain};
                pg8::gemm_phase<EpiAny, pg8::StaticOrder, true>(c.lds, g, S, E);
            }
        }
        if (EN(2)) {
            FRESH();
            const int nmu = lastffn ? 0 : (k == 0 || k == 9) ? DFF / 16 : (k == 1 || k == 10 || k == 7) ? DM / 32 : k == 3 ? 80 : k == 4 ? 12 + 16 : 0;
            for (int mu = (2 * c.bid >= c.G) ? c.G - 1 - c.bid : nmu; mu < nmu; mu += c.G / 2) {
                FRESH();
                bf16_t* HB = c.W<bf16_t>(WS_HB); bf16_t* ACT = c.W<bf16_t>(WS_ACT);
                MDesc m;
                if (k == 0 || k == 9) { const int a0 = 16 * mu; m = MDesc{HB + (size_t)RMAIN * DM, c.W<bf16_t>(k == 0 ? WS_WGU1 : WS_WGU2), DM, DM, DM, 256 * (a0 >> 7) + (a0 & 127), 128, MK_SWIGLU, 0.f}; }
                else if (k == 1 || k == 10) m = MDesc{ACT + (size_t)RMAIN * DFF, c.W<bf16_t>(k == 1 ? WS_WD1 : WS_WD2), DFF, DFF, DFF, 32 * mu, 16, MK_RESID, 0.5f};
                else if (k == 7) m = MDesc{HB + (size_t)RMAIN * DM, c.W<bf16_t>(WS_WOUT), DM, DM, DM, 32 * mu, 16, MK_RESID, 1.f};
                else if (k == 3) m = MDesc{HB + (size_t)RMAIN * DM, c.W<bf16_t>(WS_WIN), DM, DM, DM, 32 * mu, 16, MK_IN, 0.f};
                else if (mu < 12) m = MDesc{c.W<bf16_t>(WS_CQ) + (size_t)RMAIN * 256, c.W<bf16_t>(WS_WUQ), 256, 256, 256, 32 * mu, 16, MK_UQ, 0.f};
                else m = MDesc{c.W<bf16_t>(WS_CKV) + (size_t)RMAIN * 128, c.W<bf16_t>(WS_WUKV), 128, 128, 128, 32 * (mu - 12), 16, MK_UKV, 0.f};
                unsigned char* ws = c.ws; float* hm = c.hmeta; const int lane = c.lane;
                meta_unit(c, m.A, m.lda, m.Bt, m.ldb, m.K, m.n0, m.off2, [&](int r, int ca, f32x4 va, int cb, f32x4 vb) {
                    if (m.kind == MK_SWIGLU) {
                        const int a0 = 128 * (m.n0 >> 8) + (m.n0 & 127);
                        u32x2 w; w.x = pk2(silu_f(va[0]) * vb[0], silu_f(va[1]) * vb[1]); w.y = pk2(silu_f(va[2]) * vb[2], silu_f(va[3]) * vb[3]);
                        *(u32x2*)((bf16_t*)(ws + WS_ACT) + (size_t)(RMAIN + r) * DFF + a0 + (ca - m.n0)) = w;
                    } else if (m.kind == MK_RESID) {
                        const float* bm = (l == 0 && k == 1) ? INP(p, I_META) : (const float*)hm;
                        *(f32x4*)(hm + (size_t)r * DM + ca) = *(const f32x4*)(bm + (size_t)r * DM + ca) * ALPHA + va * m.s;
                        *(f32x4*)(hm + (size_t)r * DM + cb) = *(const f32x4*)(bm + (size_t)r * DM + cb) * ALPHA + vb * m.s;
                    } else if (m.kind == MK_IN) {
                        InStore st{(bf16_t*)(ws + WS_Z), (bf16_t*)(ws + WS_XBC), (bf16_t*)(ws + WS_FQ), (bf16_t*)(ws + WS_FK), (bf16_t*)(ws + WS_CQ), (bf16_t*)(ws + WS_CKV), (float*)(ws + WS_SMALL), (bf16_t*)(ws + WS_FV)};
                        st.store4(RMAIN + r, ca, va); st.store4(RMAIN + r, cb, vb);
                        if (ca >= 1792 && ca < 2176) {
                            float sq = va[0] * va[0] + va[1] * va[1] + va[2] * va[2] + va[3] * va[3] + vb[0] * vb[0] + vb[1] * vb[1] + vb[2] * vb[2] + vb[3] * vb[3];
                            sq += __shfl_xor(sq, 16); sq += __shfl_xor(sq, 32);
                            if ((lane >> 4) == 0) atomicAdd((float*)(ws + (ca < 2048 ? WS_SSQQ : WS_SSQKV)) + (size_t)(RMAIN + r) * 4, sq);
                        }
                    } else if (m.kind == MK_UQ) {
                        UqStore{(bf16_t*)(ws + WS_QM), (const float*)(ws + WS_SSQQ), (const f32x2*)(ws + WS_ROPE)}.store(RMAIN + r, m.n0, ca - m.n0, va, vb);
                    } else {
                        if (ca < 256) { UkStore uks{(bf16_t*)(ws + WS_KM), (const float*)(ws + WS_SSQKV)}; uks.store4(RMAIN + r, ca, va); uks.store4(RMAIN + r, cb, vb); }
                        else { const float sc = __builtin_amdgcn_rsqf(ssq4((const float*)(ws + WS_SSQKV), RMAIN + r) * (1.f / 128.f) + EPS); bf16_t* vm = (bf16_t*)(ws + WS_VM) + (size_t)(RMAIN + r) * 256;
                            u32x2 w; w.x = pk2(va[0] * sc, va[1] * sc); w.y = pk2(va[2] * sc, va[3] * sc); *(u32x2*)(vm + (ca - 256)) = w;
                            w.x = pk2(vb[0] * sc, vb[1] * sc); w.y = pk2(vb[2] * sc, vb[3] * sc); *(u32x2*)(vm + (cb - 256)) = w; }
                    }
                });
            }
        }
        FRESH();
        const int gtid = c.bid * 512 + c.tid, GT = c.G * 512;
        bf16_t* HB = c.W<bf16_t>(WS_HB);
        unsigned* ctl = c.W<unsigned>(WS_CTL);
        LAS int* s_item = (LAS int*)(c.lds + 133120);
        if (EN(0) && ph == 0) {
            convert_weights(c, 0);
            f32x2* rope = c.W<f32x2>(WS_ROPE);
            for (int i = gtid; i < LTOT * 16; i += GT) {
                const int pos = i >> 4, fi = i & 15;
                const float inv = exp2f(-(float)fi * (13.287712379549449f / 16.f));
                const float ang = (float)pos * inv;
                float t = ang * 0.15915494309189535f; t = t - rintf(t);
                rope[i] = (f32x2){__builtin_amdgcn_cosf(t), __builtin_amdgcn_sinf(t)};
            }
            for (int i = gtid; i < RT * 256; i += GT) {
                const int row = i >> 8, c4 = i & 255;
                const f32x4 v = row < RMAIN ? ((const f32x4*)INP(p, I_X))[(size_t)row * 256 + c4] : ((const f32x4*)INP(p, I_META))[(size_t)(row - RMAIN) * 256 + c4];
                u32x2 w; w.x = pk2(v[0], v[1]); w.y = pk2(v[2], v[3]); ((u32x2*)(HB + (size_t)row * DM))[c4] = w;
            }
        } else if (EN(3) && (k == 2 || k == 8 || k == 11)) {
            const int gi = k == 2 ? I_LN1G : k == 8 ? I_LN2G : I_LN3G;
            const bool last = (l == 1 && k == 11);
            ln_rows(c, INP(p, gi) + l * DM, INP(p, gi + 1) + l * DM, last ? nullptr : HB, last ? RMAIN : RT);
            if (k == 2) {
                float* z1 = c.W<float>(WS_SSQQ); float* z2 = c.W<float>(WS_SSQKV); float* z3 = c.W<float>(WS_SSQS);
                for (int i = gtid; i < NMETA * 4; i += GT) { z1[(size_t)RMAIN * 4 + i] = 0.f; z2[(size_t)RMAIN * 4 + i] = 0.f; } (void)z3;
                if (gtid == 0) ctl[0] = 0u;
            }
            if (k == 11 && l == 0) convert_weights(c, 1);
        } else if (EN(8) && k == 4) {
            bf16_t* Km = c.W<bf16_t>(WS_KM);
#ifndef SKIP_P6
            {
                const bf16_t* XBC = c.W<bf16_t>(WS_XBC); bf16_t* XC = c.W<bf16_t>(WS_XC); bf16_t* BN = c.W<bf16_t>(WS_BN); bf16_t* CN = c.W<bf16_t>(WS_CN);
                const float* cw = INP(p, I_CONVW) + (size_t)l * 4 * 768; const float* cbias = INP(p, I_CONVB) + (size_t)l * 768;
                auto nat_finish = [&](int row, int cg8, int pos, const u32x4 (&xv4)[4]) {
                    float acc8[8];
                    { const f32x4 b0 = *(const f32x4*)(cbias + cg8), b1 = *(const f32x4*)(cbias + cg8 + 4);
                      acc8[0] = b0[0]; acc8[1] = b0[1]; acc8[2] = b0[2]; acc8[3] = b0[3]; acc8[4] = b1[0]; acc8[5] = b1[1]; acc8[6] = b1[2]; acc8[7] = b1[3]; }
#pragma unroll
                    for (int kk = 0; kk < 4; ++kk) {
                        if (pos - 3 + kk >= 0) {
                            const u32x4 xv = xv4[kk];
                            const f32x4 w0 = *(const f32x4*)(cw + kk * 768 + cg8), w1 = *(const f32x4*)(cw + kk * 768 + cg8 + 4);
                            acc8[0] += w0[0] * bf2f(xv.x & 0xffffu); acc8[1] += w0[1] * bf2f(xv.x >> 16); acc8[2] += w0[2] * bf2f(xv.y & 0xffffu); acc8[3] += w0[3] * bf2f(xv.y >> 16);
                            acc8[4] += w1[0] * bf2f(xv.z & 0xffffu); acc8[5] += w1[1] * bf2f(xv.z >> 16); acc8[6] += w1[2] * bf2f(xv.w & 0xffffu); acc8[7] += w1[3] * bf2f(xv.w >> 16);
                        }
                    }
                    u32x4 o; o.x = pk2(silu_f(acc8[0]), silu_f(acc8[1])); o.y = pk2(silu_f(acc8[2]), silu_f(acc8[3])); o.z = pk2(silu_f(acc8[4]), silu_f(acc8[5])); o.w = pk2(silu_f(acc8[6]), silu_f(acc8[7]));
                    if (cg8 < 512) *(u32x4*)(XC + (size_t)row * 512 + cg8) = o; else if (cg8 < 640) *(u32x4*)(BN + (size_t)row * 128 + cg8 - 512) = o; else *(u32x4*)(CN + (size_t)row * 128 + cg8 - 640) = o;
                };
                for (int ia = gtid; ia < RT * 96; ia += 2 * GT) {
                    const int ib0 = ia + GT; const bool hb = ib0 < RT * 96; const int ib = hb ? ib0 : ia;
                    const int rowa = ia / 96, cga = (ia % 96) * 8, posa = pos_of_row(rowa), ba = rowa < RMAIN ? rowa >> 11 : 0;
                    const int rowb = ib / 96, cgb = (ib % 96) * 8, posb = pos_of_row(rowb), bb = rowb < RMAIN ? rowb >> 11 : 0;
                    u32x4 xa[4], xb[4];
#pragma unroll
                    for (int kk = 0; kk < 4; ++kk) { const int pa = posa - 3 + kk, pb = posb - 3 + kk;
                        xa[kk] = *(const u32x4*)(XBC + (size_t)row_of(ba, pa < 0 ? 0 : pa) * 768 + cga); xb[kk] = *(const u32x4*)(XBC + (size_t)row_of(bb, pb < 0 ? 0 : pb) * 768 + cgb); }
                    nat_finish(rowa, cga, posa, xa);
                    if (hb) nat_finish(rowb, cgb, posb, xb);
                }
            }
            {
                const float* SM = c.W<float>(WS_SMALL); float* dtv = c.W<float>(WS_DTV); const float* dtb = INP(p, I_DTB) + l * 8;
                for (int i = gtid; i < RT * 8; i += GT) { const int row = i >> 3, hh = i & 7; const float x = SM[(size_t)row * 64 + 32 + hh] + dtb[hh];
                    dtv[i] = fmaxf(x, 0.f) + log1pf(__expf(-fabsf(x))); }
                const f32x2* rp = c.W<f32x2>(WS_ROPE);
                for (int i = gtid; i < RT * 16; i += GT) { const int row = i >> 4, fi = i & 15; const f32x2 cs = rp[(size_t)pos_of_row(row) * 16 + fi];
                    const float x1 = SM[(size_t)row * 64 + fi], x2 = SM[(size_t)row * 64 + 16 + fi];
                    const bf16_t o1 = (bf16_t)(pk2(x1 * cs.x - x2 * cs.y, 0.f) & 0xffffu), o2 = (bf16_t)(pk2(x2 * cs.x + x1 * cs.y, 0.f) & 0xffffu);
#pragma unroll
                    for (int hh = 0; hh < 4; ++hh) { Km[(size_t)row * 384 + hh * 96 + 64 + fi] = o1; Km[(size_t)row * 384 + hh * 96 + 80 + fi] = o2; } }
                float* cbv = c.W<float>(WS_CB); const float* ffb = INP(p, I_FFB) + l * 4;
                const int gw = c.bid * 8 + c.wid;
                if (gw < 32) {
                    const int b = gw >> 2, hh = gw & 3; const float fb = ffb[hh];
                    float v[33]; float s = 0.f;
#pragma unroll
                    for (int i = 0; i < 33; ++i) { const int pos = c.lane * 33 + i; float lf = 0.f;
                        if (pos < LTOT) { const float x = SM[(size_t)row_of(b, pos) * 64 + 40 + hh] + fb; lf = fminf(x, 0.f) - log1pf(__expf(-fabsf(x))); }
                        s += lf; v[i] = s; }
                    float t = s;
#pragma unroll
                    for (int o = 1; o < 64; o <<= 1) { const float u = __shfl_up(t, o); if (c.lane >= o) t += u; }
                    const float base = t - s;
#pragma unroll
                    for (int i = 0; i < 33; ++i) { const int pos = c.lane * 33 + i; if (pos < LTOT) cbv[(size_t)(b * 4 + hh) * LP + pos] = -(base + v[i]) * LOG2E; }
                }
            }
#endif
        } else if (EN(6) && k == 5) {
            bf16_t* MIX = HB;
            const bf16_t* FQ = c.W<bf16_t>(WS_FQ); const bf16_t* FK = c.W<bf16_t>(WS_FK); const bf16_t* FV = c.W<bf16_t>(WS_FV); const float* cbv = c.W<float>(WS_CB);
            const bf16_t* Qm = c.W<bf16_t>(WS_QM); const bf16_t* Km = c.W<bf16_t>(WS_KM); const bf16_t* Vm = c.W<bf16_t>(WS_VM);
            int qn = 0; (void)qn;
            for (;;) {
                __syncthreads();
#ifdef STATIC_Q
                if (c.tid == 0) { *s_item = c.bid + qn * c.G; } ++qn;
#else
                if (c.tid == 0) *s_item = (int)atomicAdd(ctl, 1u);
#endif
                __syncthreads();
                int it = *s_item; asm volatile("" : "+v"(it)); it = __builtin_amdgcn_readfirstlane(it);
                if (it >= 128 + 1024 + 8) break;
                FRESH();
#ifndef SKIP_SSD
#ifdef DUP_K
                if (it < 128 && rep > 0) continue;
#endif
                if (it < 128) { ssd_item_seq(c, it >> 4, (it >> 1) & 7, it & 1, l); continue; }
#endif
                int j, mixer, bh;
                if (it < 128 + 1024) { const int r = it - 128; j = 16 - (r >> 6); mixer = (r >> 5) & 1; bh = r & 31; }
                else { const int r = it - 128 - 1024; j = 0; mixer = r >> 2; bh = r & 3; }
                const int b = bh >> 2, hh = bh & 3;
#ifndef SKIP_FOX
                if (mixer == 0) attn_item<64, true>(c, FQ + hh * 64, FK + hh * 64, 256, FV + hh * 64, 256, cbv + (size_t)(b * 4 + hh) * LP, MIX, 512 + hh * 64, b, j);
#endif
#ifndef SKIP_MLA
                if (mixer == 1) attn_item<96, false>(c, Qm + hh * 96, Km + hh * 96, 384, Vm + hh * 64, 256, nullptr, MIX, 768 + hh * 64, b, j);
#endif
            }
        } else if (EN(7) && k == 6) {
            bf16_t* MIX = HB; const float* ng = INP(p, I_SNG) + l * 512;
            for (int i = gtid; i < RT * 64; i += GT) {
                const int row = i >> 6, c8 = (i & 63) * 8;
                u32x4* q = (u32x4*)(MIX + (size_t)row * DM + c8); const u32x4 v = *q;
                const float t0 = bf2f(v.x & 0xffffu), t1 = bf2f(v.x >> 16), t2 = bf2f(v.y & 0xffffu), t3 = bf2f(v.y >> 16), t4 = bf2f(v.z & 0xffffu), t5 = bf2f(v.z >> 16), t6 = bf2f(v.w & 0xffffu), t7 = bf2f(v.w >> 16);
                float ss = ((t0 * t0 + t1 * t1) + (t2 * t2 + t3 * t3)) + ((t4 * t4 + t5 * t5) + (t6 * t6 + t7 * t7));
                ss += __shfl_xor(ss, 1); ss += __shfl_xor(ss, 2); ss += __shfl_xor(ss, 4); ss += __shfl_xor(ss, 8); ss += __shfl_xor(ss, 16);
                const float rs = __builtin_amdgcn_rsqf(ss * (1.f / 256.f) + EPS);
                const f32x4 g0 = *(const f32x4*)(ng + c8), g1 = *(const f32x4*)(ng + c8 + 4);
                u32x4 o;
                o.x = pk2(t0 * rs * g0[0], t1 * rs * g0[1]); o.y = pk2(t2 * rs * g0[2], t3 * rs * g0[3]); o.z = pk2(t4 * rs * g1[0], t5 * rs * g1[1]); o.w = pk2(t6 * rs * g1[2], t7 * rs * g1[3]);
                *q = o;
            }
        }
        }
#if MK_LAUNCHES == 1
        if (ph + 1 < p.ph_hi) {
            if (ph == 0) cg::this_grid().sync();
            else xcd_barrier(xbar);
        }
#endif
    }
}

extern "C" void kernel_launch(void* const* d_in, const int* in_sizes, int n_in, void* d_out, int out_size, void* d_ws, size_t ws_size, hipStream_t stream) {
    static int grid = 0;
    if (grid == 0) {
        if (n_in != 27 || ws_size < WS_END) { fprintf(stderr, "kernel_launch: unexpected inputs (n_in %d, ws %zu, need %zu)\n", n_in, ws_size, (size_t)WS_END); grid = -1; return; }
        int dev = 0, cus = 0, per_cu = 0;
        (void)hipGetDevice(&dev); (void)hipDeviceGetAttribute(&cus, hipDeviceAttributeMultiprocessorCount, dev);
        const void* fn = (const void*)mk_fwd<PH_MASK>;
        if (hipFuncSetAttribute(fn, hipFuncAttributeMaxDynamicSharedMemorySize, LDS_BYTES) != hipSuccess) { fprintf(stderr, "kernel_launch: hipFuncSetAttribute failed\n"); grid = -1; return; }
        if (hipOccupancyMaxActiveBlocksPerMultiprocessor(&per_cu, fn, 512, LDS_BYTES) != hipSuccess || per_cu < 1) { fprintf(stderr, "kernel_launch: occupancy query failed (%d)\n", per_cu); (void)hipGetLastError(); per_cu = 1; }
        grid = cus * per_cu;
    }
    if (grid < 0) return;
    if (hipMemsetAsync((char*)d_ws + WS_BAR, 0, 16384, stream) != hipSuccess) { fprintf(stderr, "kernel_launch: hipMemsetAsync failed\n"); return; }
    Params prm{};
    for (int i = 0; i < 27; ++i) prm.in[i] = (const float*)d_in[i];
    prm.out = (float*)d_out; prm.ws = (unsigned char*)d_ws;
#ifndef NPH_LIMIT
#define NPH_LIMIT 25
#endif
    constexpr int NPH = NPH_LIMIT;
#if MK_LAUNCHES == 1
    prm.ph_lo = 0; prm.ph_hi = NPH;
    void* args[] = {&prm};
    hipError_t e = hipLaunchCooperativeKernel((const void*)mk_fwd<PH_MASK>, dim3(grid), dim3(512), args, LDS_BYTES, stream);
    if (e != hipSuccess) fprintf(stderr, "cooperative launch failed: %s (grid %d)\n", hipGetErrorString(e), grid);
#else
    for (int ph = 0; ph < NPH; ++ph) { prm.ph_lo = ph; prm.ph_hi = ph + 1; hipLaunchKernelGGL(mk_fwd<PH_MASK>, dim3(grid), dim3(512), LDS_BYTES, stream, prm); }
#endif
}
```
